# Optimizing an MI355X kernel written in HIP

```python
import math
import jax, jax.numpy as jnp
from jax import lax
import numpy as np

D_MODEL = 1024
BATCH = 16
SEQ = 2048
DEPTH = 2

H_A = 8
D_A = 64
H_I = 4
D_I = 64
TOPK_MAX = 256
H_B = 4
D_B = 64
D_FF = 2816
CONV_W = 3
PLE_DIM = 256
ROPE_THETA = 10000.0
Q_BLOCK = 128
EPS = 1e-6

W_A = H_A * D_A
W_B = H_B * 2 * D_B
N_IN = W_A + D_A + D_A + H_I * D_I + D_I + H_I + 2 * (H_B * 2 * D_B) + W_B + 2 * D_MODEL

kernel_name = 'hybrid_dsa_diffattn_convffn_ple'


def _split_points():
    sizes = [W_A, D_A, D_A, H_I * D_I, D_I, H_I, H_B * 2 * D_B, H_B * 2 * D_B, W_B, D_MODEL, D_MODEL]
    pts, acc = [], 0
    for s in sizes[:-1]:
        acc += s
        pts.append(acc)
    return pts


def rms_norm(x, g):
    xf = x.astype(jnp.float32)
    y = xf * lax.rsqrt(jnp.mean(xf * xf, axis=-1, keepdims=True) + EPS)
    return (y * g.astype(jnp.float32)).astype(x.dtype)


def rope_tables(length, dim):
    inv = 1.0 / (ROPE_THETA ** (jnp.arange(0, dim, 2, dtype=jnp.float32) / dim))
    ang = jnp.arange(length, dtype=jnp.float32)[:, None] * inv[None, :]
    return jnp.cos(ang), jnp.sin(ang)


def apply_rope(x, cos, sin):
    half = x.shape[-1] // 2
    shape = (cos.shape[0],) + (1,) * (x.ndim - 3) + (half,)
    c, s = cos.reshape(shape), sin.reshape(shape)
    xf = x.astype(jnp.float32)
    x1, x2 = xf[..., :half], xf[..., half:]
    return jnp.concatenate([x1 * c - x2 * s, x2 * c + x1 * s], axis=-1).astype(x.dtype)


def gather_rows(t, idx):
    return jax.vmap(lambda tb, ib: tb[ib])(t, idx)


def token_mixers(u, w_in, g_qa, g_ka, g_qb, g_kb, lam_q1, lam_k1, lam_q2, lam_k2,
                 g_subln, w_branch_a, w_branch_b, w_out, lam_init, cos, sin):
    bsz, length, _ = u.shape
    k_top = min(TOPK_MAX, length // 4)
    proj = u @ w_in
    qa, ka, va, qi, ki, wi, qb, kb, vb, gate_a, gate_b = jnp.split(proj, _split_points(), axis=-1)

    qa = apply_rope(rms_norm(qa.reshape(bsz, length, H_A, D_A), g_qa), cos, sin)
    ka = apply_rope(rms_norm(ka, g_ka), cos, sin)
    qi = apply_rope(qi.reshape(bsz, length, H_I, D_I), cos, sin)
    ki = apply_rope(ki, cos, sin)
    wi = wi * (H_I ** -0.5 * D_I ** -0.5)

    qb = apply_rope(rms_norm(qb.reshape(bsz, length, H_B, 2, D_B), g_qb), cos, sin)
    kb = apply_rope(rms_norm(kb.reshape(bsz, length, H_B, 2, D_B), g_kb), cos, sin)
    q1, q2 = qb[..., 0, :], qb[..., 1, :]
    k1, k2 = kb[..., 0, :], kb[..., 1, :]
    vb = vb.reshape(bsz, length, H_B, 2 * D_B)
    lam = (jnp.exp(jnp.sum(lam_q1.astype(jnp.float32) * lam_k1.astype(jnp.float32)))
           - jnp.exp(jnp.sum(lam_q2.astype(jnp.float32) * lam_k2.astype(jnp.float32))) + lam_init)

    scale_a = D_A ** -0.5
    scale_b = D_B ** -0.5
    s_pos = jnp.arange(length)

    def qslice(t, start):
        return lax.dynamic_slice_in_dim(t, start, Q_BLOCK, axis=1)

    def block(start):
        t_pos = start + jnp.arange(Q_BLOCK)
        causal = s_pos[None, :] <= t_pos[:, None]
        rel = jax.nn.relu(jnp.einsum('bthd,bsd->bths', qslice(qi, start), ki).astype(jnp.float32))
        iscore = jnp.einsum('bths,bth->bts', rel, qslice(wi, start).astype(jnp.float32))
        iscore = jnp.where(causal[None], iscore, -jnp.inf)
        _, sel = lax.top_k(iscore, k_top)
        k_sel = gather_rows(ka, sel)
        v_sel = gather_rows(va, sel)
        logit = jnp.einsum('bthd,btkd->bthk', qslice(qa, start), k_sel).astype(jnp.float32) * scale_a
        valid = (sel <= t_pos[None, :, None])[:, :, None, :]
        attn_a = jax.nn.softmax(jnp.where(valid, logit, -jnp.inf), axis=-1)
        o_a = jnp.einsum('bthk,btkd->bthd', attn_a.astype(va.dtype), v_sel)
        s1 = jnp.einsum('bthd,bshd->bhts', qslice(q1, start), k1).astype(jnp.float32) * scale_b
        s2 = jnp.einsum('bthd,bshd->bhts', qslice(q2, start), k2).astype(jnp.float32) * scale_b
        a1 = jax.nn.softmax(jnp.where(causal, s1, -jnp.inf), axis=-1)
        a2 = jax.nn.softmax(jnp.where(causal, s2, -jnp.inf), axis=-1)
        o_b = jnp.einsum('bhts,bshe->bthe', (a1 - lam * a2).astype(vb.dtype), vb)
        return o_a, o_b

    starts = jnp.arange(0, length, Q_BLOCK, dtype=jnp.int32)
    o_a, o_b = lax.map(block, starts)
    o_a = jnp.moveaxis(o_a, 0, 1).reshape(bsz, length, W_A)
    o_b = jnp.moveaxis(o_b, 0, 1).reshape(bsz, length, H_B, 2 * D_B)
    o_b = (rms_norm(o_b, g_subln) * (1.0 - lam_init)).reshape(bsz, length, W_B)

    mix = jax.nn.sigmoid(gate_a) * (o_a @ w_branch_a) + jax.nn.sigmoid(gate_b) * (o_b @ w_branch_b)
    return mix @ w_out


def conv_ffn(u, w_up, conv_w, conv_b, w_down):
    up = u @ w_up
    pad = jnp.pad(up, ((0, 0), (CONV_W - 1, 0), (0, 0)))
    length = up.shape[1]
    conv = conv_b + sum(pad[:, j:j + length] * conv_w[j] for j in range(CONV_W))
    gate, val = jnp.split(conv, 2, axis=-1)
    return (jax.nn.gelu(gate, approximate=True) * val) @ w_down


def setup_inputs(seed: int = 0) -> dict:
    key = jax.random.key(seed)
    ks = jax.random.split(key, 24)
    f32 = jnp.float32

    def nrm(k, shape, scale):
        return jax.random.normal(k, shape, f32) * scale

    def gain(k, shape):
        return 1.0 + 0.05 * jax.random.normal(k, shape, f32)

    return {
        'x': nrm(ks[0], (BATCH, SEQ, D_MODEL), 1.0),
        'p': nrm(ks[1], (DEPTH, BATCH, SEQ, PLE_DIM), 1.0),
        'g_mix_norm': gain(ks[2], (DEPTH, D_MODEL)),
        'w_in': nrm(ks[3], (DEPTH, D_MODEL, N_IN), D_MODEL ** -0.5),
        'g_qa': gain(ks[4], (DEPTH, D_A)),
        'g_ka': gain(ks[5], (DEPTH, D_A)),
        'g_qb': gain(ks[6], (DEPTH, D_B)),
        'g_kb': gain(ks[7], (DEPTH, D_B)),
        'lam_q1': nrm(ks[8], (DEPTH, D_B), 0.1),
        'lam_k1': nrm(ks[9], (DEPTH, D_B), 0.1),
        'lam_q2': nrm(ks[10], (DEPTH, D_B), 0.1),
        'lam_k2': nrm(ks[11], (DEPTH, D_B), 0.1),
        'g_subln': gain(ks[12], (DEPTH, 2 * D_B)),
        'w_branch_a': nrm(ks[13], (DEPTH, W_A, D_MODEL), W_A ** -0.5),
        'w_branch_b': nrm(ks[14], (DEPTH, W_B, D_MODEL), W_B ** -0.5),
        'w_out': nrm(ks[15], (DEPTH, D_MODEL, D_MODEL), D_MODEL ** -0.5),
        'g_ffn_norm': gain(ks[16], (DEPTH, D_MODEL)),
        'w_up': nrm(ks[17], (DEPTH, D_MODEL, 2 * D_FF), D_MODEL ** -0.5),
        'conv_w': nrm(ks[18], (DEPTH, CONV_W, 2 * D_FF), CONV_W ** -0.5),
        'conv_b': nrm(ks[19], (DEPTH, 2 * D_FF), 0.02),
        'w_down': nrm(ks[20], (DEPTH, D_FF, D_MODEL), D_FF ** -0.5),
        'g_ple_norm': gain(ks[21], (DEPTH, D_MODEL)),
        'w_ple_gate': nrm(ks[22], (DEPTH, D_MODEL, D_MODEL), D_MODEL ** -0.5),
        'w_ple_proj': nrm(ks[23], (DEPTH, PLE_DIM, D_MODEL), PLE_DIM ** -0.5),
    }


def reference(x, p, g_mix_norm, w_in, g_qa, g_ka, g_qb, g_kb, lam_q1, lam_k1, lam_q2, lam_k2,
              g_subln, w_branch_a, w_branch_b, w_out, g_ffn_norm, w_up, conv_w, conv_b, w_down,
              g_ple_norm, w_ple_gate, w_ple_proj):
    length = x.shape[1]
    cos, sin = rope_tables(length, D_A)
    h = x
    for i in range(DEPTH):
        lam_init = 0.8 - 0.6 * math.exp(-0.3 * i)
        u = rms_norm(h, g_mix_norm[i])
        h = h + token_mixers(u, w_in[i], g_qa[i], g_ka[i], g_qb[i], g_kb[i], lam_q1[i], lam_k1[i],
                             lam_q2[i], lam_k2[i], g_subln[i], w_branch_a[i], w_branch_b[i], w_out[i],
                             lam_init, cos, sin)
        h = h + conv_ffn(rms_norm(h, g_ffn_norm[i]), w_up[i], conv_w[i], conv_b[i], w_down[i])
        ple_gate = jax.nn.sigmoid(rms_norm(h, g_ple_norm[i]) @ w_ple_gate[i])
        h = h + ple_gate * (p[i].astype(h.dtype) @ w_ple_proj[i])
    return h
```

```cpp
#include <hip/hip_runtime.h>
#include <hip/hip_cooperative_groups.h>
#include <cstdio>
#include <cstdint>
namespace cg = cooperative_groups;
#define DI __device__ __forceinline__
#define LAS __attribute__((address_space(3)))
typedef float f32x2 __attribute__((ext_vector_type(2)));
typedef __bf16 bf16x2_t __attribute__((ext_vector_type(2)));
typedef float f32x16 __attribute__((ext_vector_type(16)));
typedef short s16x4 __attribute__((ext_vector_type(4)));
typedef unsigned u32x2 __attribute__((ext_vector_type(2)));
DI unsigned pk2(float a, float b) { f32x2 v = {a, b}; bf16x2_t r = __builtin_convertvector(v, bf16x2_t); return __builtin_bit_cast(unsigned, r); }
DI float bflo(unsigned w) { return __uint_as_float(w << 16); }
DI float bfhi(unsigned w) { return __uint_as_float(w & 0xffff0000u); }
DI float sigm(float x) { return __builtin_amdgcn_rcpf(1.f + __builtin_amdgcn_exp2f(-1.4426950408889634f * x)); }
namespace pg8 {
#define PG8_LAS __attribute__((address_space(3)))
typedef unsigned short bf16_t;
typedef short bf16x8 __attribute__((ext_vector_type(8)));
typedef float f32x4 __attribute__((ext_vector_type(4)));
typedef unsigned u32x4 __attribute__((ext_vector_type(4)));
constexpr int BM = 256, BK = 64, HALF = 128, HTB = HALF * BK * 2  , STAGE_BYTES = 8 * HTB, NXCD = 8, WGM = 8;

__host__ __device__ __forceinline__ int lds_byte(int r, int c) { const int st = (r >> 4) * 2 + (c >> 5), rr = r & 15, cc = c & 31, ob = rr * 64 + cc * 2; return st * 1024 + (ob ^ (((ob >> 9) & 1) << 5)); }
__host__ __device__ __forceinline__ void stage_rc(int b, int& R, int& C) { const int st = b / 1024, sb = b % 1024, swz = sb ^ (((sb >> 9) & 1) << 5); R = (st >> 1) * 16 + swz / 64; C = (st & 1) * 32 + (swz % 64) / 2; }
__host__ __device__ __forceinline__ int perm32(int rho) { const int n = rho >> 4, i = rho & 15; return 8 * (i >> 2) + 4 * n + (i & 3); }

struct Unit { int pm, pn; };
struct Gemm { const bf16_t* A; const bf16_t* Bt; int M, N, K, lda; };

struct StaticOrder {
    int nM, nN, nwg, G, c;
    __host__ __device__ void init(int M, int N, int G_, int c_) { nM = M / BM; nN = N / BM; nwg = nM * nN; G = G_; c = c_; }
    __host__ __device__ bool next(int i, Unit& u) const {
        const long L = (long)i * G + c; if (L >= nwg) return false;
        int wgid = (int)L; { const int q = nwg / NXCD, r = nwg % NXCD, xcd = wgid % NXCD, off = wgid / NXCD; wgid = (xcd < r ? xcd * (q + 1) : r * (q + 1) + (xcd - r) * q) + off; }
        const int nig = WGM * nN, gid = wgid / nig, fm = gid * WGM, gsz = (nM - fm) < WGM ? (nM - fm) : WGM;
        u.pm = fm + ((wgid % nig) % gsz); u.pn = (wgid % nig) / gsz; return true;
    }
    __device__ __forceinline__ void a_ready(const Unit&) const {}
    __device__ __forceinline__ void done(const Unit&) const {}
};

template <int ACT  , bool RS = false  > struct EpiStore {
    static constexpr bool PERM = true, AFTER_DRAIN = false;
    bf16_t* O; int ldc; const float* rs;
    __device__ __forceinline__ void operator()(const f32x4 (&acc)[2][2][4][2], const Unit& u, int wr, int wc, int fr, int fq) const {
        { int ln_; asm volatile("v_mbcnt_lo_u32_b32 %0, -1, 0\n\tv_mbcnt_hi_u32_b32 %0, -1, %0" : "=v"(ln_)); fr = ln_ & 15; fq = ln_ >> 4; }
        const int row0 = u.pm * BM + wr * 64 + fr, col0 = u.pn * BM + wc * 32 + 8 * fq;
        float rsv[2][4];
        if (RS) {
#pragma unroll
            for (int ai = 0; ai < 2; ++ai)
#pragma unroll
                for (int m = 0; m < 4; ++m) rsv[ai][m] = rs[row0 + ai * HALF + m * 16];
        }
#pragma unroll
        for (int ai = 0; ai < 2; ++ai)
#pragma unroll
            for (int m = 0; m < 4; ++m) { bf16_t* rowp = O + (size_t)(row0 + ai * HALF + m * 16) * ldc + col0;
#pragma unroll
                for (int bj = 0; bj < 2; ++bj) { f32x4 v0 = acc[ai][bj][m][0], v1 = acc[ai][bj][m][1];
                    if (RS) { v0 = v0 * rsv[ai][m]; v1 = v1 * rsv[ai][m]; }
                    if (ACT == 1) {
#pragma unroll
                        for (int e = 0; e < 4; ++e) { v0[e] = sigm(v0[e]); v1[e] = sigm(v1[e]); } }
                    u32x4 w; w.x = pk2(v0[0], v0[1]); w.y = pk2(v0[2], v0[3]); w.z = pk2(v1[0], v1[1]); w.w = pk2(v1[2], v1[3]);
                    *(u32x4*)(rowp + bj * HALF) = w; } }
    }
};
template <bool ADD> struct EpiGate {
    static constexpr bool PERM = true, AFTER_DRAIN = false;
    bf16_t* O; int ldc; const bf16_t* gate; int ldg;
    __device__ __forceinline__ void operator()(const f32x4 (&acc)[2][2][4][2], const Unit& u, int wr, int wc, int fr, int fq) const {
        { int ln_; asm volatile("v_mbcnt_lo_u32_b32 %0, -1, 0\n\tv_mbcnt_hi_u32_b32 %0, -1, %0" : "=v"(ln_)); fr = ln_ & 15; fq = ln_ >> 4; }
        const int row0 = u.pm * BM + wr * 64 + fr, col0 = u.pn * BM + wc * 32 + 8 * fq;
        constexpr int NM = 4;
#pragma unroll
        for (int ai = 0; ai < 2; ++ai)
#pragma unroll
            for (int mp = 0; mp < 4 / NM; ++mp) {
                u32x4 g[NM][2], o[NM][2];
#pragma unroll
                for (int mm = 0; mm < NM; ++mm)
#pragma unroll
                    for (int bj = 0; bj < 2; ++bj) { const size_t row = (size_t)(row0 + ai * HALF + (NM * mp + mm) * 16);
                        g[mm][bj] = *(const u32x4*)(gate + row * ldg + col0 + bj * HALF);
                        if (ADD) o[mm][bj] = *(const u32x4*)(O + row * ldc + col0 + bj * HALF); }
#pragma unroll
                for (int mm = 0; mm < NM; ++mm)
#pragma unroll
                    for (int bj = 0; bj < 2; ++bj) { const int m = NM * mp + mm; const size_t row = (size_t)(row0 + ai * HALF + m * 16);
                        const f32x4 v0 = acc[ai][bj][m][0], v1 = acc[ai][bj][m][1]; const u32x4 gg = g[mm][bj];
                        float r0 = sigm(bflo(gg.x)) * v0[0], r1 = sigm(bfhi(gg.x)) * v0[1], r2 = sigm(bflo(gg.y)) * v0[2], r3 = sigm(bfhi(gg.y)) * v0[3];
                        float r4 = sigm(bflo(gg.z)) * v1[0], r5 = sigm(bfhi(gg.z)) * v1[1], r6 = sigm(bflo(gg.w)) * v1[2], r7 = sigm(bfhi(gg.w)) * v1[3];
                        if (ADD) { const u32x4 oo = o[mm][bj];
                            r0 += bflo(oo.x); r1 += bfhi(oo.x); r2 += bflo(oo.y); r3 += bfhi(oo.y); r4 += bflo(oo.z); r5 += bfhi(oo.z); r6 += bflo(oo.w); r7 += bfhi(oo.w); }
                        u32x4 w; w.x = pk2(r0, r1); w.y = pk2(r2, r3); w.z = pk2(r4, r5); w.w = pk2(r6, r7);
                        *(u32x4*)(O + row * ldc + col0 + bj * HALF) = w; }
            }
    }
};
__device__ __forceinline__ float bperm_xor(float v, int m, int lane) { return __int_as_float(__builtin_amdgcn_ds_bpermute((lane ^ m) << 2, __float_as_int(v))); }
template <bool GMUL> struct EpiRes {
    static constexpr bool PERM = false, AFTER_DRAIN = false;
    const float* base32; const bf16_t* base16; float* out32; int ldc; const bf16_t* G; bf16_t* HB; float* PSSQ;
    template <int NM, bool B32> __device__ __forceinline__ void group(const f32x4 (&acc)[2][2][4][2], const Unit& u, int wc, int fq, int ln_, int row0, int col0, int ai, int m0) const {
        f32x4 b32[B32 ? NM : 1][2][2]; u32x2 b16[B32 ? 1 : NM][2][2]; u32x2 g[NM][2][2]; float ssq[NM];
#pragma unroll
        for (int mm = 0; mm < NM; ++mm) { ssq[mm] = 0.f;
#pragma unroll
            for (int bj = 0; bj < 2; ++bj)
#pragma unroll
                for (int n = 0; n < 2; ++n) { const size_t o2 = (size_t)(row0 + ai * HALF + (m0 + mm) * 16) * ldc + col0 + bj * HALF + n * 16;
                    if (B32) b32[mm][bj][n] = *(const f32x4*)(base32 + o2); else b16[mm][bj][n] = *(const u32x2*)(base16 + o2);
                    if (GMUL) g[mm][bj][n] = *(const u32x2*)(G + o2); } }
#pragma unroll
        for (int mm = 0; mm < NM; ++mm) {
#pragma unroll
            for (int bj = 0; bj < 2; ++bj)
#pragma unroll
                for (int n = 0; n < 2; ++n) { const int m = m0 + mm; const size_t o2 = (size_t)(row0 + ai * HALF + m * 16) * ldc + col0 + bj * HALF + n * 16;
                    f32x4 v = acc[ai][bj][m][n];
                    if (GMUL) { const u32x2 gg = g[mm][bj][n]; v[0] *= bflo(gg.x); v[1] *= bfhi(gg.x); v[2] *= bflo(gg.y); v[3] *= bfhi(gg.y); }
                    f32x4 bb;
                    if (B32) bb = b32[mm][bj][n]; else { const u32x2 t = b16[mm][bj][n]; bb = (f32x4){bflo(t.x), bfhi(t.x), bflo(t.y), bfhi(t.y)}; }
                    const f32x4 o = bb + v;
                    if (out32) *(f32x4*)(out32 + o2) = o;
                    ssq[mm] += (o[0] * o[0] + o[1] * o[1]) + (o[2] * o[2] + o[3] * o[3]);
                    if (HB) { u32x2 w; w.x = pk2(o[0], o[1]); w.y = pk2(o[2], o[3]); *(u32x2*)(HB + o2) = w; } }
            float s = ssq[mm]; s += bperm_xor(s, 16, ln_); s += bperm_xor(s, 32, ln_);
            if (fq == 0) PSSQ[(size_t)(row0 + ai * HALF + (m0 + mm) * 16) * 16 + u.pn * 4 + wc] = s;
        }
    }
    __device__ __forceinline__ void operator()(const f32x4 (&acc)[2][2][4][2], const Unit& u, int wr, int wc, int fr, int fq) const {
        int ln_; asm volatile("v_mbcnt_lo_u32_b32 %0, -1, 0\n\tv_mbcnt_hi_u32_b32 %0, -1, %0" : "=v"(ln_)); fr = ln_ & 15; fq = ln_ >> 4;
        const int row0 = u.pm * BM + wr * 64 + fr, col0 = u.pn * BM + wc * 32 + 4 * fq;
        if (base32) {
#pragma unroll
            for (int ai = 0; ai < 2; ++ai)
#pragma unroll
                for (int mp = 0; mp < 2; ++mp) group<2, true>(acc, u, wc, fq, ln_, row0, col0, ai, 2 * mp);
        } else {
#pragma unroll
            for (int ai = 0; ai < 2; ++ai) group<4, false>(acc, u, wc, fq, ln_, row0, col0, ai, 0);
        }
    }
};
template <class Epi, class Sched, bool ALIGN_EPI = false, bool SP2 = false>
__device__ __forceinline__ void gemm_phase(PG8_LAS unsigned char* lds, const Gemm g, const Sched& S, const Epi& E, const int tid_in) {
    const int tid = tid_in, wid = __builtin_amdgcn_readfirstlane(tid >> 6), lane = tid & 63, wr = wid >> 2, wc = wid & 3, fr = lane & 15, fq = lane >> 4;
    float zf_ = 0.f; asm volatile("" : "+v"(zf_));
    const int K = g.K, nt = K / BK;
    unsigned voffA[2], voffB[2];
#pragma unroll
    for (int i = 0; i < 2; ++i) { int R, C; stage_rc(tid * 16 + i * 8192, R, C); const int Rb = Epi::PERM ? ((R & ~31) + perm32(R & 31)) : R;
        voffA[i] = (unsigned)(R * g.lda + C) * 2u; voffB[i] = (unsigned)(Rb * K + C) * 2u; }
    const size_t kstep = (size_t)(BK * 2);
    const size_t hstepB = (size_t)HALF * K * 2; const size_t hstepA = (size_t)HALF * g.lda * 2;
    const size_t tstepA = 2 * hstepA; const size_t tstepB = 2 * hstepB;
    const unsigned ldsw = (unsigned)wid * 1024u;
    const int aoff = lds_byte(wr * 64 + fr, fq * 8), boff = lds_byte(wc * 32 + fr, fq * 8);
#define PG8_SA(b, h) (((b) * 2 + (h)) * HTB)
#define PG8_SB(b, h) ((4 + (b) * 2 + (h)) * HTB)
#define PG8_STAGE(bufoff, gbase, voff) do { _Pragma("unroll") for (int _i = 0; _i < 2; ++_i) \
        __builtin_amdgcn_global_load_lds((const unsigned*)((const char*)(gbase) + (voff)[_i]), (PG8_LAS unsigned*)(lds + (bufoff) + ldsw + _i * 8192), 16, 0, 0); } while (0)
#define PG8_LDA(dst, b, h) do { _Pragma("unroll") for (int m = 0; m < 4; ++m) _Pragma("unroll") for (int k = 0; k < 2; ++k) dst[m][k] = *(const PG8_LAS bf16x8*)(lds + PG8_SA(b, h) + aoff + m * 2048 + k * 1024); } while (0)
#define PG8_LDB(dst, b, h) do { _Pragma("unroll") for (int n = 0; n < 2; ++n) _Pragma("unroll") for (int k = 0; k < 2; ++k) dst[n][k] = *(const PG8_LAS bf16x8*)(lds + PG8_SB(b, h) + boff + n * 2048 + k * 1024); } while (0)
#define PG8_MMA(ai, bj, At, Bt) do { __builtin_amdgcn_s_setprio(1); _Pragma("unroll") for (int m = 0; m < 4; ++m) _Pragma("unroll") for (int n = 0; n < 2; ++n) _Pragma("unroll") for (int k = 0; k < 2; ++k) \
        acc[ai][bj][m][n] = __builtin_amdgcn_mfma_f32_16x16x32_bf16(Bt[n][k], At[m][k], acc[ai][bj][m][n], 0, 0, 0); __builtin_amdgcn_s_setprio(0); } while (0)
#define PG8_WAIT_V(n) asm volatile("s_waitcnt vmcnt(" #n ")" ::: "memory")
#define PG8_WAIT_L(n) asm volatile("s_waitcnt lgkmcnt(" #n ")" ::: "memory")
#define PG8_BAR __builtin_amdgcn_s_barrier()
#define PG8_SCHED __builtin_amdgcn_sched_barrier(0)
    Unit cur, nxt; int ui = 0;
    if (!S.next(0, cur)) return;
    f32x4 acc[2][2][4][2];
#pragma unroll
    for (int a = 0; a < 2; ++a)
#pragma unroll
        for (int b = 0; b < 2; ++b)
#pragma unroll
            for (int m = 0; m < 4; ++m)
#pragma unroll
                for (int n = 0; n < 2; ++n) acc[a][b][m][n] = (f32x4){zf_, zf_, zf_, zf_};
    bf16x8 At[4][2], B0[2][2], B1[2][2];
    const char* cA = (const char*)g.A + (size_t)cur.pm * tstepA; const char* cB = (const char*)g.Bt + (size_t)cur.pn * tstepB;
    S.a_ready(cur);
    if constexpr (SP2) {
        PG8_STAGE(PG8_SB(0, 0), cB, voffB); PG8_STAGE(PG8_SB(0, 1), cB + hstepB, voffB); PG8_STAGE(PG8_SA(0, 0), cA, voffA); PG8_STAGE(PG8_SA(0, 1), cA + hstepA, voffA);
        if (wr == 1) PG8_BAR;
        PG8_WAIT_V(2); PG8_BAR;
        PG8_STAGE(PG8_SB(1, 0), cB + kstep, voffB); PG8_STAGE(PG8_SA(1, 0), cA + kstep, voffA); PG8_STAGE(PG8_SB(1, 1), cB + hstepB + kstep, voffB);
        PG8_WAIT_V(6); PG8_BAR;
    } else {
        PG8_STAGE(PG8_SB(0, 0), cB, voffB); PG8_STAGE(PG8_SA(0, 0), cA, voffA); PG8_STAGE(PG8_SB(0, 1), cB + hstepB, voffB); PG8_STAGE(PG8_SA(0, 1), cA + hstepA, voffA);
        if (wr == 1) PG8_BAR;
        PG8_WAIT_V(4); PG8_BAR;
        PG8_STAGE(PG8_SB(1, 0), cB + kstep, voffB); PG8_STAGE(PG8_SA(1, 0), cA + kstep, voffA); PG8_STAGE(PG8_SB(1, 1), cB + hstepB + kstep, voffB);
        PG8_WAIT_V(6); PG8_BAR;
    }
    for (;;) {
        const bool has_next = S.next(ui + 1, nxt);
        const char* nA = has_next ? (const char*)g.A + (size_t)nxt.pm * tstepA : cA; const char* nB = has_next ? (const char*)g.Bt + (size_t)nxt.pn * tstepB : cB;
        for (int t = 0; t < nt; t += 2) {
            const bool last = (t == nt - 2);
            const char* a1 = cA + (size_t)(t + 1) * kstep;
            const char* a2 = last ? nA : cA + (size_t)(t + 2) * kstep; const char* b2 = last ? nB : cB + (size_t)(t + 2) * kstep;
            const char* a3 = a2 + kstep; const char* b3 = b2 + kstep;
            if (last && has_next) S.a_ready(nxt);
            if constexpr (SP2) {
            PG8_LDB(B0, 0, 0); PG8_LDB(B1, 0, 1); PG8_SCHED; PG8_LDA(At, 0, 0); PG8_STAGE(PG8_SA(1, 1), a1 + hstepA, voffA);
            PG8_WAIT_V(8); PG8_WAIT_L(0); PG8_BAR; PG8_MMA(0, 0, At, B0); PG8_MMA(0, 1, At, B1); PG8_BAR; PG8_SCHED;
            PG8_LDA(At, 0, 1); PG8_STAGE(PG8_SB(0, 0), b2, voffB); PG8_STAGE(PG8_SB(0, 1), b2 + hstepB, voffB); PG8_STAGE(PG8_SA(0, 0), a2, voffA);
            PG8_WAIT_V(8); PG8_WAIT_L(0); PG8_BAR; PG8_MMA(1, 0, At, B0); PG8_MMA(1, 1, At, B1); PG8_BAR; PG8_SCHED;
            PG8_LDB(B0, 1, 0); PG8_LDB(B1, 1, 1); PG8_SCHED; PG8_LDA(At, 1, 0); PG8_STAGE(PG8_SA(0, 1), a2 + hstepA, voffA);
            PG8_WAIT_V(8); PG8_WAIT_L(0); PG8_BAR; PG8_MMA(0, 0, At, B0); PG8_MMA(0, 1, At, B1); PG8_BAR; PG8_SCHED;
            PG8_LDA(At, 1, 1); PG8_STAGE(PG8_SB(1, 0), b3, voffB); PG8_STAGE(PG8_SB(1, 1), b3 + hstepB, voffB); PG8_STAGE(PG8_SA(1, 0), a3, voffA);
            PG8_WAIT_V(8); PG8_WAIT_L(0); PG8_BAR; PG8_MMA(1, 0, At, B0); PG8_MMA(1, 1, At, B1); PG8_BAR; PG8_SCHED;
            } else {
            PG8_LDB(B0, 0, 0); PG8_SCHED; PG8_LDA(At, 0, 0); PG8_STAGE(PG8_SA(1, 1), a1 + hstepA, voffA);
            PG8_WAIT_L(8); PG8_BAR; PG8_WAIT_L(0); PG8_MMA(0, 0, At, B0); PG8_BAR; PG8_SCHED;
            PG8_LDB(B1, 0, 1); PG8_STAGE(PG8_SB(0, 0), b2, voffB);
            PG8_BAR; PG8_WAIT_L(0); PG8_MMA(0, 1, At, B1); PG8_BAR;
            PG8_LDA(At, 0, 1); PG8_STAGE(PG8_SA(0, 0), a2, voffA);
            PG8_BAR; PG8_WAIT_L(0); PG8_MMA(1, 0, At, B0); PG8_BAR; PG8_SCHED;
            PG8_STAGE(PG8_SB(0, 1), b2 + hstepB, voffB);
            PG8_WAIT_V(6); PG8_BAR; PG8_MMA(1, 1, At, B1); PG8_BAR;
            PG8_LDB(B0, 1, 0); PG8_SCHED; PG8_LDA(At, 1, 0); PG8_STAGE(PG8_SA(0, 1), a2 + hstepA, voffA);
            PG8_WAIT_L(8); PG8_BAR; PG8_WAIT_L(0); PG8_MMA(0, 0, At, B0); PG8_BAR; PG8_SCHED;
            PG8_LDB(B1, 1, 1); PG8_STAGE(PG8_SB(1, 0), b3, voffB);
            PG8_BAR; PG8_WAIT_L(0); PG8_MMA(0, 1, At, B1); PG8_BAR;
            PG8_LDA(At, 1, 1); PG8_STAGE(PG8_SA(1, 0), a3, voffA);
            PG8_BAR; PG8_WAIT_L(0); PG8_MMA(1, 0, At, B0); PG8_BAR; PG8_SCHED;
            PG8_STAGE(PG8_SB(1, 1), b3 + hstepB, voffB);
            PG8_WAIT_V(6); PG8_BAR; PG8_MMA(1, 1, At, B1); PG8_BAR;
            }
        }
        if constexpr (ALIGN_EPI) { if (wr == 0) PG8_BAR; }
        if constexpr (!Epi::AFTER_DRAIN) { E(acc, cur, wr, wc, fr, fq); S.done(cur); }
        if (!has_next) break;
#pragma unroll
        for (int a = 0; a < 2; ++a)
#pragma unroll
            for (int b = 0; b < 2; ++b)
#pragma unroll
                for (int m = 0; m < 4; ++m)
#pragma unroll
                    for (int n = 0; n < 2; ++n) acc[a][b][m][n] = (f32x4){zf_, zf_, zf_, zf_};
        cur = nxt; cA = nA; cB = nB; ++ui;
        if constexpr (ALIGN_EPI) { if (wr == 1) PG8_BAR; }
    }
    PG8_WAIT_V(0);
    if constexpr (!ALIGN_EPI) { if (wr == 0) PG8_BAR; }
    PG8_BAR;
    if constexpr (Epi::AFTER_DRAIN) { E.fused(acc, cur, wr, wc, fr, fq, lds, wid, lane); S.done(cur); }
#undef PG8_SA
#undef PG8_SB
#undef PG8_STAGE
#undef PG8_LDA
#undef PG8_LDB
#undef PG8_MMA
#undef PG8_WAIT_V
#undef PG8_WAIT_L
#undef PG8_BAR
#undef PG8_SCHED
}
}
using pg8::bf16_t; using pg8::bf16x8; using pg8::f32x4; using pg8::u32x4;
#define MFMA32(a, b, c) __builtin_amdgcn_mfma_f32_32x32x16_bf16((a), (b), (c), 0, 0, 0)
constexpr int DM = 1024, NB = 16, SEQ = 2048, M = NB * SEQ, DEPTH = 2;
constexpr int NIN = 4548, NINP = 4608, DFF = 2816, NUP = 5632, PLE = 256;
constexpr int C_QA = 0, C_KA = 512, C_VA = 576, C_QI = 640, C_KI = 896, C_QB = 960, C_KB = 1472, C_VB = 1984, C_GA = 2496, C_GB = 3520, C_WI = 4544;
constexpr float EPS = 1e-6f;
constexpr float QSCALE = 0.125f * 1.4426950408889634f;
constexpr size_t MiB = 1u << 20;
constexpr size_t WS_ROPE = 1 * MiB;
constexpr size_t WS_WIN = 2 * MiB, SZ_WIN = (size_t)NINP * DM * 2;
constexpr size_t WS_WUP = WS_WIN + 18 * MiB, SZ_WUP = (size_t)NUP * DM * 2;
constexpr size_t WS_WDN = WS_WUP + 22 * MiB, SZ_WDN = (size_t)DM * DFF * 2;
constexpr size_t WS_WBA = WS_WDN + 11 * MiB, SZ_WB = (size_t)DM * 512 * 2;
constexpr size_t WS_WBB = WS_WBA + 2 * MiB;
constexpr size_t WS_WOUT = WS_WBB + 2 * MiB, SZ_WSQ = (size_t)DM * DM * 2;
constexpr size_t WS_WPG = WS_WOUT + 4 * MiB;
constexpr size_t WS_WPP = WS_WPG + 4 * MiB, SZ_WPP = (size_t)DM * PLE * 2;
constexpr size_t WS_PB = 66 * MiB;
constexpr size_t WS_XN = 82 * MiB;
constexpr size_t WS_PROJ = 146 * MiB;
constexpr size_t WS_VTA = 434 * MiB, WS_VTB = 438 * MiB, WS_MASK = 470 * MiB, WS_END = 478 * MiB;
constexpr size_t WS_UP = WS_PROJ, WS_ACT = WS_PROJ + 176 * MiB, WS_G = WS_PROJ;
constexpr size_t WS_HB = WS_XN;
constexpr size_t WS_HB2 = 434 * MiB;
constexpr size_t WS_MIX = 434 * MiB;
constexpr size_t WS_RSTD = 498 * MiB, WS_PSSQ = 499 * MiB, WS_END2 = 502 * MiB;
static_assert(WS_WPP + 2 * SZ_WPP <= WS_PB, "weights fit");
constexpr int MC = M / 2;
constexpr int LDS_BYTES = 147456;
constexpr int NWAVES = 8, NTHR = 512;

struct Args { const float* in[24]; float* out; unsigned char* ws; };

DI float shx(float v, int o, int lane) { return __int_as_float(__builtin_amdgcn_ds_bpermute((lane ^ o) << 2, __float_as_int(v))); }
DI float wave_sum(float v, int lane) {
#pragma unroll
    for (int o = 1; o < 64; o <<= 1) v += shx(v, o, lane);
    return v;
}
DI int crow(int i, int h) { return (i & 3) + 8 * (i >> 2) + 4 * h; }

template <int MAP> DI void transpose_item(const float* W, int K, int Nsrc, int Ndst, bf16_t* WT, LAS float* scr, int item, int lane, const float* gk = nullptr) {
    const int nblk = Ndst / 32, kb = item / nblk, nb = item % nblk, k0 = 64 * kb, n0 = 32 * nb;
    int nd = n0 + (lane & 31), ns = nd;
    if (MAP == 1) ns = nd < 960 ? nd : (nd < 4544 ? nd + 4 : (nd < 4548 ? nd - 3584 : -1));
    float wv[32];
#pragma unroll
    for (int i = 0; i < 32; ++i) { const int kk = 2 * i + (lane >> 5); wv[i] = ns >= 0 ? __builtin_nontemporal_load(W + (size_t)(k0 + kk) * Nsrc + ns) : 0.f; }
#pragma unroll
    for (int i = 0; i < 32; ++i) { const int kk = 2 * i + (lane >> 5); scr[kk * 33 + (lane & 31)] = gk ? wv[i] * gk[k0 + kk] : wv[i]; }
    asm volatile("s_waitcnt lgkmcnt(0)" ::: "memory");
    const int c = lane & 7;
#pragma unroll
    for (int j = 0; j < 4; ++j) { const int n = (lane >> 3) + 8 * j; const LAS float* s = scr + (8 * c) * 33 + n;
        u32x4 o; o.x = pk2(s[0 * 33], s[1 * 33]); o.y = pk2(s[2 * 33], s[3 * 33]); o.z = pk2(s[4 * 33], s[5 * 33]); o.w = pk2(s[6 * 33], s[7 * 33]);
        *(u32x4*)(WT + (size_t)(n0 + n) * K + k0 + 8 * c) = o; }
    asm volatile("s_waitcnt lgkmcnt(0)" ::: "memory");
}
DI void rms_row_to_bf16(const float* xrow, const float* g, bf16_t* orow, int lane) {
    const f32x4* xr = (const f32x4*)xrow + lane; const f32x4* gr = (const f32x4*)g + lane;
    f32x4 v[4]; float s = 0.f;
#pragma unroll
    for (int j = 0; j < 4; ++j) { v[j] = xr[64 * j]; s += (v[j].x * v[j].x + v[j].y * v[j].y) + (v[j].z * v[j].z + v[j].w * v[j].w); }
    const float rstd = 1.0f / sqrtf(wave_sum(s, lane) * (1.f / DM) + EPS);
    unsigned long long* o8 = (unsigned long long*)orow + lane;
#pragma unroll
    for (int j = 0; j < 4; ++j) { const f32x4 gg = gr[64 * j];
        o8[64 * j] = (unsigned long long)pk2(v[j].x * rstd * gg.x, v[j].y * rstd * gg.y) | ((unsigned long long)pk2(v[j].z * rstd * gg.z, v[j].w * rstd * gg.w) << 32); }
}
DI void raw_row_to_bf16(const float* xrow, bf16_t* orow, float* rstd_out, int lane) {
    const f32x4* xr = (const f32x4*)xrow + lane;
    f32x4 v[4]; float s = 0.f;
#pragma unroll
    for (int j = 0; j < 4; ++j) { v[j] = __builtin_nontemporal_load(xr + 64 * j); s += (v[j].x * v[j].x + v[j].y * v[j].y) + (v[j].z * v[j].z + v[j].w * v[j].w); }
    const float rstd = 1.0f / sqrtf(wave_sum(s, lane) * (1.f / DM) + EPS);
    unsigned long long* o8 = (unsigned long long*)orow + lane;
#pragma unroll
    for (int j = 0; j < 4; ++j) o8[64 * j] = (unsigned long long)pk2(v[j].x, v[j].y) | ((unsigned long long)pk2(v[j].z, v[j].w) << 32);
    if (lane == 0) *rstd_out = rstd;
}
DI void rstd_phase(const float* pssq, float* rstd, int gtid, int nthr) {
    for (int row = gtid; row < M; row += nthr) { const f32x4* p = (const f32x4*)(pssq + (size_t)row * 16); const f32x4 a = p[0], b = p[1], c = p[2], d = p[3];
        const float s = ((a.x + a.y) + (a.z + a.w)) + ((b.x + b.y) + (b.z + b.w)) + ((c.x + c.y) + (c.z + c.w)) + ((d.x + d.y) + (d.z + d.w));
        rstd[row] = 1.0f / sqrtf(s * (1.f / DM) + EPS); }
}
DI void rms_phase(const float* src, const float* g, bf16_t* dst, int gw, int ngw, int lane) {
    for (int m = gw; m < M; m += ngw) rms_row_to_bf16(src + (size_t)m * DM, g, dst + (size_t)m * DM, lane);
}
DI void rope_table(float* rope, int gtid, int nthr) {
    for (int idx = gtid; idx < SEQ * 32; idx += nthr) {
        const int t = idx >> 5, i = idx & 31;
        double inv = 1.0; const double c = 0.74989420933245582730;
        for (int k = 0; k < i; ++k) inv *= c;
        const float invf = (float)inv; const float ang = (float)t * invf;
        const double x = (double)ang; const double kk = __builtin_rint(x * 0.15915494309189533577);
        double r = __builtin_fma(-kk, 6.283185307179586232, x); r = __builtin_fma(-kk, 2.4492935982947064e-16, r);
        const double r2 = r * r; double s = 1.0, co = 1.0;
#pragma unroll
        for (int n = 13; n >= 1; --n) { s = 1.0 - r2 * (1.0 / ((2.0 * n) * (2.0 * n + 1.0))) * s; co = 1.0 - r2 * (1.0 / ((2.0 * n - 1.0) * (2.0 * n))) * co; }
        s *= r;
        rope[2 * idx] = (float)co; rope[2 * idx + 1] = (float)s;
    }
}
DI void qk_post_token(bf16_t* prow, const float* rope_t, const float* g_qa, const float* g_ka, const float* g_qb, const float* g_kb, int lane) {
    const int c = lane & 7, vsub = lane >> 3;
    u32x4 w[4];
#pragma unroll
    for (int L = 0; L < 4; ++L) { const int vid = 8 * L + vsub; const int col = vid * 64 + (vid >= 9 ? 64 : 0) + 8 * c;
        w[L] = (vid < 30) ? __builtin_nontemporal_load((const u32x4*)(prow + col)) : (u32x4){0u, 0u, 0u, 0u}; }
    float cs[8], sn[8];
#pragma unroll
    for (int q = 0; q < 4; ++q) { const f32x4 t = *(const f32x4*)(rope_t + 16 * (c & 3) + 4 * q); cs[2 * q] = t.x; sn[2 * q] = t.y; cs[2 * q + 1] = t.z; sn[2 * q + 1] = t.w; }
    const float sgn = c < 4 ? -1.f : 1.f;
#pragma unroll
    for (int L = 0; L < 4; ++L) {
        const int vid = 8 * L + vsub;
        const int ty = vid < 8 ? 0 : vid == 8 ? 1 : vid < 14 ? 4 : vid < 22 ? 2 : 3;
        float x[8] = {bflo(w[L].x), bfhi(w[L].x), bflo(w[L].y), bfhi(w[L].y), bflo(w[L].z), bfhi(w[L].z), bflo(w[L].w), bfhi(w[L].w)};
        float ss = 0.f;
#pragma unroll
        for (int e = 0; e < 8; ++e) ss += x[e] * x[e];
        ss += shx(ss, 1, lane); ss += shx(ss, 2, lane); ss += shx(ss, 4, lane);
        const float* gp = ty == 0 ? g_qa : ty == 1 ? g_ka : ty == 2 ? g_qb : g_kb;
        const float rstd = ty < 4 ? 1.0f / sqrtf(ss * (1.f / 64.f) + EPS) : 1.f;
        const float sc = (ty == 0 || ty == 2) ? QSCALE : 1.f;
        const f32x4 ga = *(const f32x4*)(gp + 8 * c), gb = *(const f32x4*)(gp + 8 * c + 4);
        const float gg[8] = {ga.x, ga.y, ga.z, ga.w, gb.x, gb.y, gb.z, gb.w};
        float y[8];
#pragma unroll
        for (int e = 0; e < 8; ++e) { x[e] = ty < 4 ? x[e] * rstd * gg[e] : x[e]; }
#pragma unroll
        for (int e = 0; e < 8; ++e) { const float p = shx(x[e], 4, lane); y[e] = (x[e] * cs[e] + sgn * p * sn[e]) * sc; }
        u32x4 o; o.x = pk2(y[0], y[1]); o.y = pk2(y[2], y[3]); o.z = pk2(y[4], y[5]); o.w = pk2(y[6], y[7]);
        const int col = vid * 64 + (vid >= 9 ? 64 : 0) + 8 * c;
        if (vid < 30) *(u32x4*)(prow + col) = o;
    }
}
DI void vt_tile(const bf16_t* PROJ, bf16_t* VTA, bf16_t* VTB, LAS bf16_t* tl, int tile, int lane) {
    const int tb = tile / 9, ct = tile % 9; const int row0 = tb * 64, b = row0 / SEQ, t0 = row0 % SEQ;
    const int col0 = ct == 0 ? C_VA : C_VB + 64 * (ct - 1);
    bf16_t* dst = ct == 0 ? VTA + (size_t)b * 64 * SEQ : VTB + ((size_t)b * 512 + 64 * (ct - 1)) * SEQ;
#pragma unroll
    for (int p = 0; p < 8; ++p) { const int tok = 8 * p + (lane >> 3), ch = lane & 7;
        const u32x4 v = __builtin_nontemporal_load((const u32x4*)(PROJ + (size_t)(row0 + tok) * NINP + col0 + 8 * ch));
        LAS bf16_t* q = tl + (8 * ch) * 72 + tok;
        q[0 * 72] = (bf16_t)(v.x & 0xffff); q[1 * 72] = (bf16_t)(v.x >> 16); q[2 * 72] = (bf16_t)(v.y & 0xffff); q[3 * 72] = (bf16_t)(v.y >> 16);
        q[4 * 72] = (bf16_t)(v.z & 0xffff); q[5 * 72] = (bf16_t)(v.z >> 16); q[6 * 72] = (bf16_t)(v.w & 0xffff); q[7 * 72] = (bf16_t)(v.w >> 16); }
    asm volatile("s_waitcnt lgkmcnt(0)" ::: "memory");
#pragma unroll
    for (int p = 0; p < 8; ++p) { const int c = 8 * p + (lane >> 3), tch = lane & 7;
        const u32x4 v = *(const LAS u32x4*)(tl + c * 72 + 8 * tch);
        *(u32x4*)(dst + (size_t)c * SEQ + t0 + 8 * tch) = v; }
    asm volatile("s_waitcnt lgkmcnt(0)" ::: "memory");
}
DI float gelu_tanh(float x) { const float u = 0.7978845608028654f * (x + 0.044715f * x * x * x); return x * __builtin_amdgcn_rcpf(1.f + __builtin_amdgcn_exp2f(-2.f * 1.4426950408889634f * u)); }
DI f32x4 unpk4(u32x2 a) { return (f32x4){bflo(a.x), bfhi(a.x), bflo(a.y), bfhi(a.y)}; }
typedef float f32x8_ __attribute__((ext_vector_type(8)));
DI f32x8_ unpk8(u32x4 a) { return (f32x8_){bflo(a.x), bfhi(a.x), bflo(a.y), bfhi(a.y), bflo(a.z), bfhi(a.z), bflo(a.w), bfhi(a.w)}; }
DI f32x8_ ld8(const float* p) { const f32x4 a = *(const f32x4*)p, b = *(const f32x4*)(p + 4); return (f32x8_){a.x, a.y, a.z, a.w, b.x, b.y, b.z, b.w}; }
DI void conv_phase(const bf16_t* UP, bf16_t* ACT, const float* cw, const float* cb, int gtid, int nthr) {
    constexpr int NG = DFF / 8, RUN = 16, NTASK = (MC / RUN) * NG;
    for (int task = gtid; task < NTASK; task += nthr) {
        const int cgp = task % NG, tr = task / NG, c0 = cgp * 8, r0 = tr * RUN, tpos = r0 % SEQ;
        f32x8_ wg[3], wv[3];
#pragma unroll
        for (int j = 0; j < 3; ++j) { wg[j] = ld8(cw + (size_t)j * NUP + c0); wv[j] = ld8(cw + (size_t)j * NUP + DFF + c0); }
        const f32x8_ bg = ld8(cb + c0), bv = ld8(cb + DFF + c0);
        f32x8_ g2 = {0.f, 0.f, 0.f, 0.f, 0.f, 0.f, 0.f, 0.f}, g1 = g2, v2 = g2, v1 = g2;
        const bf16_t* up = UP + (size_t)r0 * NUP + c0;
        if (tpos != 0) {
            g2 = unpk8(*(const u32x4*)(up - 2 * (size_t)NUP)); g1 = unpk8(*(const u32x4*)(up - (size_t)NUP));
            v2 = unpk8(*(const u32x4*)(up - 2 * (size_t)NUP + DFF)); v1 = unpk8(*(const u32x4*)(up - (size_t)NUP + DFF));
        }
#pragma unroll 4
        for (int i = 0; i < RUN; ++i) {
            const f32x8_ g0 = unpk8(__builtin_nontemporal_load((const u32x4*)(up + (size_t)i * NUP))), v0 = unpk8(__builtin_nontemporal_load((const u32x4*)(up + (size_t)i * NUP + DFF)));
            const f32x8_ cg_ = bg + wg[0] * g2 + wg[1] * g1 + wg[2] * g0, cv = bv + wv[0] * v2 + wv[1] * v1 + wv[2] * v0;
            u32x4 o; o.x = pk2(gelu_tanh(cg_[0]) * cv[0], gelu_tanh(cg_[1]) * cv[1]); o.y = pk2(gelu_tanh(cg_[2]) * cv[2], gelu_tanh(cg_[3]) * cv[3]);
            o.z = pk2(gelu_tanh(cg_[4]) * cv[4], gelu_tanh(cg_[5]) * cv[5]); o.w = pk2(gelu_tanh(cg_[6]) * cv[6], gelu_tanh(cg_[7]) * cv[7]);
            __builtin_nontemporal_store(o, (u32x4*)(ACT + (size_t)(r0 + i) * DFF + c0));
            g2 = g1; g1 = g0; v2 = v1; v1 = v0;
        }
    }
}
#ifndef PROBE_ATT_VARIANT
#define PROBE_ATT_VARIANT 0
#endif
#ifndef PROBE_NBITS
#define PROBE_NBITS 1
#endif
DI int wave_count6(unsigned c) {
    int v = (int)c;
    v += __builtin_amdgcn_update_dpp(0, v, 0x111, 0xf, 0xf, false);
    v += __builtin_amdgcn_update_dpp(0, v, 0x112, 0xf, 0xf, false);
    v += __builtin_amdgcn_update_dpp(0, v, 0x114, 0xf, 0xf, false);
    v += __builtin_amdgcn_update_dpp(0, v, 0x118, 0xf, 0xf, false);
    v += __builtin_amdgcn_update_dpp(0, v, 0x142, 0xa, 0xf, false);
    v += __builtin_amdgcn_update_dpp(0, v, 0x143, 0xc, 0xf, false);
    return __builtin_amdgcn_readlane(v, 63);
}
template <int NJ, int NBITS = 32> DI void topk_row(const float* srow, int t, int lane, unsigned long long* mrow) {
    float kv[NJ];
#pragma unroll
    for (int j = 0; j < NJ; ++j) kv[j] = srow[64 * j];
#pragma unroll
    for (int g = 0; g < NJ / 8; ++g)
        asm volatile("" : "+v"(kv[8 * g]), "+v"(kv[8 * g + 1]), "+v"(kv[8 * g + 2]), "+v"(kv[8 * g + 3]), "+v"(kv[8 * g + 4]), "+v"(kv[8 * g + 5]), "+v"(kv[8 * g + 6]), "+v"(kv[8 * g + 7]));
    unsigned key[NJ];
#pragma unroll
    for (int j = 0; j < NJ; ++j) { const unsigned u = __float_as_uint(kv[j]); const unsigned mk = (u & 0x80000000u) ? ~u : (u | 0x80000000u);
        key[j] = (lane <= t - 64 * j) ? mk : 0u; }
    unsigned T = 0u;
#pragma unroll 1
    for (int bit = 31; bit >= 32 - NBITS; --bit) {
        const unsigned cand = T | (1u << bit);
        unsigned c0 = 0u;
#pragma unroll
        for (int j = 0; j < NJ; ++j) asm("v_cmp_ge_u32_e32 vcc, %1, %2\n\tv_addc_co_u32_e32 %0, vcc, 0, %0, vcc" : "+v"(c0) : "v"(key[j]), "v"(cand) : "vcc");
        const int cnt = wave_count6(c0);
        if (cnt >= 256) T = cand;
        if (cnt == 256) break;
    }
    unsigned cg = 0u, ce = 0u;
#pragma unroll
    for (int j = 0; j < NJ; ++j) { asm("v_cmp_gt_u32_e32 vcc, %1, %2\n\tv_addc_co_u32_e32 %0, vcc, 0, %0, vcc" : "+v"(cg) : "v"(key[j]), "v"(T) : "vcc");
                                   asm("v_cmp_eq_u32_e32 vcc, %1, %2\n\tv_addc_co_u32_e32 %0, vcc, 0, %0, vcc" : "+v"(ce) : "v"(key[j]), "v"(T) : "vcc"); }
    const int gt = wave_count6(cg), eq = wave_count6(ce);
    const int need = 256 - gt; int lim = SEQ;
    if (eq > need) {
        int X = 0;
#pragma unroll 1
        for (int bit = 10; bit >= 0; --bit) { const int c = X | (1 << bit); unsigned f = 0u;
#pragma unroll
            for (int j = 0; j < NJ; ++j) f += (key[j] == T && lane < c - 64 * j) ? 1u : 0u;
            if (wave_count6(f) < need) X = c; }
        lim = X + 1;
    }
    unsigned mlo = 0u, mhi = 0u;
#pragma unroll
    for (int j = 0; j < NJ; ++j) { const unsigned long long bal = __ballot(key[j] > T || (key[j] == T && lane < lim - 64 * j));
        const bool me = lane == j; mlo = me ? (unsigned)bal : mlo; mhi = me ? (unsigned)(bal >> 32) : mhi; }
    if (lane < 32) mrow[lane] = ((unsigned long long)mhi << 32) | mlo;
}

template <int PARTS> DI void idx_unit(const bf16_t* PROJ, unsigned long long* MASK64, float* scr, LAS unsigned char* lds, int b, int qb, int tid, int wave, int lane) {
    const int q0 = qb * 32;
    const size_t rowbase = (size_t)b * SEQ;
    float zf_ = 0.f; asm volatile("" : "+v"(zf_));
    if (q0 < 256) {
#pragma unroll 1
        for (int rr = 0; rr < 4; ++rr) { const int t = q0 + wave * 4 + rr;
            if (lane < 32) { const int lo = 64 * lane; const unsigned long long w = (t >= lo + 63) ? ~0ull : (t < lo ? 0ull : ((1ull << (t - lo + 1)) - 1ull)); MASK64[(rowbase + t) * 32 + lane] = w; } }
        return;
    }
    LAS float* wl = (LAS float*)lds;
    if (tid < 128) { const int q = tid >> 2, hh = tid & 3; wl[tid] = __uint_as_float((unsigned)PROJ[(rowbase + q0 + q) * NINP + C_WI + hh] << 16); }
    const int r = lane & 31, h = lane >> 5;
    constexpr int QP = 528;
    LAS unsigned char* ql = lds + 512;
#pragma unroll
    for (int p = 0; p < 2; ++p) { const int idx = tid + 512 * p, row = idx >> 5, ch = idx & 31;
        *(LAS u32x4*)(ql + row * QP + ch * 16) = *(const u32x4*)(PROJ + (rowbase + q0 + row) * NINP + C_QI + ch * 8); }
    __syncthreads();
    const int nkb = (PARTS & 1) ? q0 / 32 + 1 : 0;
    bf16x8 kfn[4];
#pragma unroll
    for (int ks = 0; ks < 4; ++ks) kfn[ks] = *(const bf16x8*)(PROJ + (rowbase + (wave < nkb ? wave : 0) * 32 + r) * NINP + C_KI + ks * 16 + h * 8);
#pragma unroll 1
    for (int kb = wave; kb < nkb; kb += 8) {
        bf16x8 kf[4];
#pragma unroll
        for (int ks = 0; ks < 4; ++ks) kf[ks] = kfn[ks];
        { const int kbn = kb + 8 < nkb ? kb + 8 : kb;
#pragma unroll
          for (int ks = 0; ks < 4; ++ks) kfn[ks] = *(const bf16x8*)(PROJ + (rowbase + kbn * 32 + r) * NINP + C_KI + ks * 16 + h * 8); }
        f32x16 sc;
#pragma unroll
        for (int i = 0; i < 16; ++i) sc[i] = zf_;
#pragma unroll
        for (int hh = 0; hh < 4; ++hh) {
            f32x16 x;
#pragma unroll
            for (int i = 0; i < 16; ++i) x[i] = zf_;
#pragma unroll
            for (int ks = 0; ks < 4; ++ks) { const bf16x8 qfr = *(const LAS bf16x8*)(ql + r * QP + hh * 128 + ks * 32 + h * 16); x = MFMA32(qfr, kf[ks], x); }
#pragma unroll
            for (int i = 0; i < 16; ++i) { const float wv = wl[crow(i, h) * 4 + hh]; sc[i] = __builtin_fmaf(wv, __builtin_fmaxf(x[i], 0.f), sc[i]); }
        }
#pragma unroll
        for (int i = 0; i < 16; ++i) scr[crow(i, h) * SEQ + kb * 32 + r] = sc[i] + 0.f;
    }
    __syncthreads();
    const int nj = (q0 + 31) / 64 + 1;
    if (PARTS & 2) {
#pragma unroll 1
        for (int rr = 0; rr < 4; ++rr) {
            const int rq = wave * 4 + rr, t = q0 + rq;
            const float* srow = scr + rq * SEQ + lane; unsigned long long* mrow = MASK64 + (rowbase + t) * 32;
            if (PARTS == 3) { if (nj <= 8) topk_row<8>(srow, t, lane, mrow); else if (nj <= 16) topk_row<16>(srow, t, lane, mrow); else if (nj <= 24) topk_row<24>(srow, t, lane, mrow); else topk_row<32>(srow, t, lane, mrow); }
            else { unsigned long long* drow = mrow + ((WS_END - WS_MASK) / 8);
                if (nj <= 8) topk_row<8, PROBE_NBITS>(srow, t, lane, drow); else if (nj <= 16) topk_row<16, PROBE_NBITS>(srow, t, lane, drow); else if (nj <= 24) topk_row<24, PROBE_NBITS>(srow, t, lane, drow); else topk_row<32, PROBE_NBITS>(srow, t, lane, drow); }
        }
    }
    __syncthreads();
}

template <int MODE, int PV = 0> DI void attn_unit(const bf16_t* PROJ, bf16_t* obase, int ldo, const bf16_t* VT, const unsigned long long* MASK64, LAS unsigned char* lds, int b, int hd, int qb,
                                      const float* gsub, float lam, float osc, int tid, int wave, int lane) {
    constexpr int NKB = MODE ? 2 : 4, NSUB = MODE ? 2 : 1, KT = 32 * NKB * NSUB;
    constexpr int DV = MODE ? 128 : 64, NDB = DV / 32;
    constexpr int KP = MODE ? 272 : 144, VP = 2 * KT + 8;
    constexpr int KBYTES = KT * KP, VBYTES = DV * VP, STAGE = KBYTES + VBYTES;
    constexpr int KCH = MODE ? 16 : 8, VCH = KT / 8;
    constexpr int NKL = KT * KCH / 512, NVL = DV * VCH / 512;
    static_assert(2 * STAGE <= LDS_BYTES - 64 && NKL >= 1 && NVL >= 1, "attention LDS stages");
    const int r = lane & 31, h = lane >> 5;
    const size_t rowbase = (size_t)b * SEQ;
    float zf_ = 0.f; asm volatile("" : "+v"(zf_));
    int q0, ntiles, qcol, kcol, koff; const bf16_t* vtbase;
    if (MODE == 0) { q0 = qb * 32; ntiles = (q0 + 31) / KT + 1; qcol = C_QA + wave * 64; kcol = C_KA; koff = 0; vtbase = VT + (size_t)b * 64 * SEQ; }
    else { const int map = wave >> 2, sub = wave & 3; q0 = qb * 128 + sub * 32; ntiles = (qb * 128 + 127) / KT + 1; qcol = C_QB + (hd * 2 + map) * 64; kcol = C_KB + hd * 128; koff = map * 128; vtbase = VT + (size_t)(b * 4 + hd) * 128 * SEQ; }
    const bf16_t* qrow = PROJ + (rowbase + q0 + r) * NINP + qcol;
    bf16x8 qf[4];
#pragma unroll
    for (int ks = 0; ks < 4; ++ks) qf[ks] = *(const bf16x8*)(qrow + ks * 16 + h * 8);
    f32x16 ot[NDB];
#pragma unroll
    for (int db = 0; db < NDB; ++db)
#pragma unroll
        for (int i = 0; i < 16; ++i) ot[db][i] = zf_;
    float nm_run = zf_, l_run = 0.f;
    u32x4 kreg[NKL], vreg[NVL];
    const bf16_t* kg[NKL]; const bf16_t* vg[NVL]; int klds[NKL], vlds[NVL];
#pragma unroll
    for (int p = 0; p < NKL; ++p) { const int idx = tid + 512 * p; const int row = idx / KCH, ch = idx % KCH;
        kg[p] = PROJ + (rowbase + row) * NINP + kcol + ch * 8; klds[p] = row * KP + ch * 16; }
#pragma unroll
    for (int p = 0; p < NVL; ++p) { const int idx = tid + 512 * p; const int d = idx / VCH, ch = idx % VCH;
        vg[p] = vtbase + (size_t)d * SEQ + ch * 8; vlds[p] = KBYTES + d * VP + ch * 16; }
#define ATT_LOAD(kt) do { _Pragma("unroll") for (int p = 0; p < NKL; ++p) kreg[p] = *(const u32x4*)(kg[p] + (size_t)(kt) * KT * NINP); \
                          _Pragma("unroll") for (int p = 0; p < NVL; ++p) vreg[p] = *(const u32x4*)(vg[p] + (kt) * KT); } while (0)
#define ATT_STORE(st) do { _Pragma("unroll") for (int p = 0; p < NKL; ++p) *(LAS u32x4*)(lds + (st) * STAGE + klds[p]) = kreg[p]; \
                           _Pragma("unroll") for (int p = 0; p < NVL; ++p) { *(LAS u32x2*)(lds + (st) * STAGE + vlds[p]) = (u32x2){vreg[p].x, vreg[p].y}; \
                                                                             *(LAS u32x2*)(lds + (st) * STAGE + vlds[p] + 8) = (u32x2){vreg[p].z, vreg[p].w}; } } while (0)
    ATT_LOAD(0); ATT_STORE(0);
    __syncthreads();
#pragma unroll 1
    for (int kt = 0; kt < ntiles; ++kt) {
        const int st = kt & 1;
        const bool more = kt + 1 < ntiles;
        if (more && PV != 1) ATT_LOAD(kt + 1);
#pragma unroll 1
        for (int sub = 0; sub < NSUB; ++sub) {
        const int key0 = kt * KT + sub * 32 * NKB;
        if ((MODE == 0 || key0 <= q0 + 31) && PV != 2) {
            unsigned long long mw[NKB / 2];
            if (MODE == 0) {
#pragma unroll
                for (int w = 0; w < NKB / 2; ++w) mw[w] = MASK64[(rowbase + q0 + r) * 32 + (key0 >> 6) + w];
            }
            f32x16 sv[NKB];
#pragma unroll
            for (int kb2 = 0; kb2 < NKB; ++kb2)
#pragma unroll
                for (int i = 0; i < 16; ++i) sv[kb2][i] = nm_run;
            const LAS unsigned char* kb_ = lds + st * STAGE + koff + sub * 32 * NKB * KP;
            float ps = 0.f, mx = -1e30f;
            unsigned long long mwv[NKB / 2];
#pragma unroll
            for (int w = 0; w < NKB / 2; ++w) mwv[w] = MODE == 0 ? mw[w] : 0ull;
            const bool diag = MODE == 1 && (key0 + 32 * NKB - 1 > q0);
            const int qq = q0 + r;
#pragma unroll
            for (int kb2 = 0; kb2 <= NKB; ++kb2) {
                if (kb2 < NKB) {
                    bf16x8 kfr[4];
#pragma unroll
                    for (int ks = 0; ks < 4; ++ks) kfr[ks] = *(const LAS bf16x8*)(kb_ + (32 * kb2 + r) * KP + ks * 32 + h * 16);
                    asm volatile("" : "+v"(kfr[0]), "+v"(kfr[1]), "+v"(kfr[2]), "+v"(kfr[3]));
#pragma unroll
                    for (int ks = 0; ks < 4; ++ks) sv[kb2] = MFMA32(kfr[ks], qf[ks], sv[kb2]);
                }
                if (kb2 > 0) {
                    constexpr int dummy = 0; (void)dummy;
                    const int j = kb2 - 1;
                    if (MODE == 0) {
                        const unsigned wsel = ((j & 1) ? (unsigned)(mwv[j >> 1] >> 32) : (unsigned)mwv[j >> 1]) >> (4 * h);
#pragma unroll
                        for (int i = 0; i < 16; ++i) { const int cb = (i & 3) + 8 * (i >> 2); if (!((wsel >> cb) & 1u)) sv[j][i] = -1e30f; }
                    } else if (diag) {
#pragma unroll
                        for (int i = 0; i < 16; ++i) { if (key0 + 32 * j + crow(i, h) > qq) sv[j][i] = -1e30f; }
                    }
#pragma unroll
                    for (int i = 0; i < 16; ++i) { mx = __builtin_fmaxf(mx, sv[j][i]); sv[j][i] = __builtin_amdgcn_exp2f(sv[j][i]); ps += sv[j][i]; }
                }
            }
            mx = __builtin_fmaxf(mx, shx(mx, 32, lane));
            if (__ballot(mx > 8.0f)) {
                const float delta = __builtin_fmaxf(mx, 0.f);
                const float alpha = __builtin_amdgcn_exp2f(-delta);
                nm_run -= delta; l_run *= alpha; ps *= alpha;
#pragma unroll
                for (int kb2 = 0; kb2 < NKB; ++kb2)
#pragma unroll
                    for (int i = 0; i < 16; ++i) sv[kb2][i] *= alpha;
#pragma unroll
                for (int db = 0; db < NDB; ++db)
#pragma unroll
                    for (int i = 0; i < 16; ++i) ot[db][i] *= alpha;
            }
            l_run += ps;
            const LAS unsigned char* vb_ = lds + st * STAGE + KBYTES + sub * 32 * NKB * 2;
#pragma unroll
            for (int kb2 = 0; kb2 < NKB; ++kb2)
#pragma unroll
                for (int s = 0; s < 2; ++s) {
                    u32x2 vlo[NDB], vhi[NDB];
#pragma unroll
                    for (int db = 0; db < NDB; ++db) { const LAS unsigned char* vp = vb_ + (32 * db + r) * VP + (32 * kb2 + 16 * s + 4 * h) * 2;
                        vlo[db] = *(const LAS u32x2*)vp; vhi[db] = *(const LAS u32x2*)(vp + 16); }
                    u32x4 pw;
                    pw.x = pk2(sv[kb2][8 * s + 0], sv[kb2][8 * s + 1]); pw.y = pk2(sv[kb2][8 * s + 2], sv[kb2][8 * s + 3]); pw.z = pk2(sv[kb2][8 * s + 4], sv[kb2][8 * s + 5]); pw.w = pk2(sv[kb2][8 * s + 6], sv[kb2][8 * s + 7]);
                    const bf16x8 pf = __builtin_bit_cast(bf16x8, pw);
                    if (NDB == 2) asm volatile("" : "+v"(vlo[0]), "+v"(vhi[0]), "+v"(vlo[1]), "+v"(vhi[1]));
                    else asm volatile("" : "+v"(vlo[0]), "+v"(vhi[0]), "+v"(vlo[1]), "+v"(vhi[1]), "+v"(vlo[NDB - 2]), "+v"(vhi[NDB - 2]), "+v"(vlo[NDB - 1]), "+v"(vhi[NDB - 1]));
#pragma unroll
                    for (int db = 0; db < NDB; ++db) { const u32x4 vw = {vlo[db].x, vlo[db].y, vhi[db].x, vhi[db].y};
                        ot[db] = MFMA32(__builtin_bit_cast(bf16x8, vw), pf, ot[db]); }
                }
        }
        }
        if (more && PV != 1) ATT_STORE(st ^ 1);
        __syncthreads();
    }
#undef ATT_LOAD
#undef ATT_STORE
    const float l = l_run + shx(l_run, 32, lane);
    const float inv = 1.0f / l;
    if (MODE == 0) {
#pragma unroll
        for (int db = 0; db < NDB; ++db)
#pragma unroll
            for (int g = 0; g < 4; ++g) { u32x2 o; o.x = pk2(ot[db][4 * g] * inv, ot[db][4 * g + 1] * inv); o.y = pk2(ot[db][4 * g + 2] * inv, ot[db][4 * g + 3] * inv);
                *(u32x2*)(obase + (rowbase + q0 + r) * ldo + wave * 64 + 32 * db + 8 * g + 4 * h) = o; }
    } else {
        LAS float* xch = (LAS float*)lds;
        const int map = wave >> 2, sub = wave & 3;
        if (map == 1) {
#pragma unroll
            for (int db = 0; db < NDB; ++db)
#pragma unroll
                for (int i = 0; i < 16; ++i) xch[((sub * 4 + db) * 16 + i) * 64 + lane] = ot[db][i] * inv;
        }
        __syncthreads();
        if (map == 0) {
            float ss = 0.f;
#pragma unroll
            for (int db = 0; db < NDB; ++db)
#pragma unroll
                for (int i = 0; i < 16; ++i) { const float o = ot[db][i] * inv - lam * xch[((sub * 4 + db) * 16 + i) * 64 + lane]; ot[db][i] = o; ss += o * o; }
            ss += shx(ss, 32, lane);
            const float rstd = osc / sqrtf(ss * (1.f / 128.f) + EPS);
            bf16_t* orow = obase + (rowbase + q0 + r) * ldo + hd * 128;
#pragma unroll
            for (int db = 0; db < NDB; ++db)
#pragma unroll
                for (int g = 0; g < 4; ++g) { const int d = 32 * db + 8 * g + 4 * h; const f32x4 gg = *(const f32x4*)(gsub + d);
                    u32x2 o; o.x = pk2(ot[db][4 * g] * rstd * gg.x, ot[db][4 * g + 1] * rstd * gg.y); o.y = pk2(ot[db][4 * g + 2] * rstd * gg.z, ot[db][4 * g + 3] * rstd * gg.w);
                    *(u32x2*)(orow + d) = o; }
        }
        __syncthreads();
    }
}

#ifndef PROBE_NBITS
#define PROBE_NBITS 1
#endif
#ifndef PROBE_IDX_PARTS
#define PROBE_IDX_PARTS 3
#endif
#ifndef PROBE_REP
#define PROBE_REP 0
#endif
typedef const __attribute__((address_space(4))) Args CArgs;
#define PH_BEGIN \
    CArgs* ap = (CArgs*)__builtin_amdgcn_kernarg_segment_ptr(); asm volatile("" : "+s"(ap)); \
    int wv_ = wave_s; asm volatile("" : "+s"(wv_)); \
    int ln_; asm volatile("v_mbcnt_lo_u32_b32 %0, -1, 0\n\tv_mbcnt_hi_u32_b32 %0, -1, %0" : "=v"(ln_)); \
    const int wave = wv_, lane = ln_; \
    const int tid = wave * 64 + lane; \
    const int G = gridDim.x, bx = blockIdx.x; \
    const int vcu = (G % 8 == 0) ? (bx % 8) * (G / 8) + bx / 8 : bx;     \
    const int gw = bx * NWAVES + wave, ngw = G * NWAVES, gtid = bx * NTHR + tid, nthr = G * NTHR; \
    unsigned char* ws = ap->ws; float* H = ap->out; \
    (void)vcu; (void)lane; (void)gw; (void)ngw; (void)gtid; (void)nthr; (void)H; (void)ws
#define XB_TMO      128
#define XB_XCNT(j)  (256  + 64 * (j))
#define XB_XSUB(j)  (1280 + 64 * (j))
#define XB_XGEN(j)  (2304 + 64 * (j))
#define XB_TOP      3328
#define XB_TOPGEN   3392
#define XB_SPIN_CAP (1u << 20)
DI unsigned xb_ld(unsigned* p)              { return __hip_atomic_load(p, __ATOMIC_RELAXED, __HIP_MEMORY_SCOPE_AGENT); }
DI unsigned xb_add(unsigned* p, unsigned v) { return __hip_atomic_fetch_add(p, v, __ATOMIC_RELAXED, __HIP_MEMORY_SCOPE_AGENT); }
DI unsigned xb_xcc_id() { return (unsigned)__builtin_amdgcn_s_getreg((3 << 11) | 20) & 0xFu; }
#define XB_SPIN(cond, bar) do { unsigned _sp = 0; while (cond) { __builtin_amdgcn_s_sleep(1); \
    if ((++_sp & 255u) == 0u) { if (xb_ld(&(bar)[XB_TMO])) break; if (_sp > XB_SPIN_CAP) { atomicAdd(&(bar)[XB_TMO], 1u); break; } } } } while (0)
DI void xb_complete(unsigned* bar, unsigned x, unsigned G, unsigned& nloc, unsigned& nx) {
    unsigned sum, cnt, mine, sp = 0u;
    for (;;) {
        sum = 0u; cnt = 0u; mine = 0u;
#pragma unroll
        for (unsigned j = 0; j < 16; ++j) { const unsigned c = xb_ld(&bar[XB_XCNT(j)]); sum += c; cnt += (c > 0u) ? 1u : 0u; mine = (j == x) ? c : mine; }
        if (sum == G) break;
        __builtin_amdgcn_s_sleep(1);
        if ((++sp & 255u) == 0u) { if (xb_ld(&bar[XB_TMO])) break; if (sp > XB_SPIN_CAP) { atomicAdd(&bar[XB_TMO], 1u); break; } }
    }
    nloc = mine > 0u ? mine : 1u; nx = cnt > 0u ? cnt : 1u;
}
DI void grid_bar(unsigned* bar, volatile LAS unsigned* st, unsigned G, int tid) {
    asm volatile("s_waitcnt vmcnt(0)" ::: "memory");
    __syncthreads();
    if (tid == 0) {
        __builtin_amdgcn_s_waitcnt(0);
        const unsigned x = xb_xcc_id();
        unsigned nloc = st[0], nx = st[1];
        if (nloc == 0u) { xb_complete(bar, x, G, nloc, nx); st[0] = nloc; st[1] = nx; }
        const unsigned old = xb_add(&bar[XB_XSUB(x)], 1u);
        const unsigned gen = old / nloc;
        if (old + 1u == (gen + 1u) * nloc) {
            __builtin_amdgcn_fence(__ATOMIC_RELEASE, "agent");
            asm volatile("s_waitcnt vmcnt(0)" ::: "memory");
            const unsigned og = xb_add(&bar[XB_TOP], 1u);
            const unsigned tg = og / nx;
            if (og + 1u == (tg + 1u) * nx) xb_add(&bar[XB_TOPGEN], 1u);
            else XB_SPIN(xb_ld(&bar[XB_TOPGEN]) == tg, bar);
            __builtin_amdgcn_fence(__ATOMIC_ACQUIRE, "agent");
            xb_add(&bar[XB_XGEN(x)], 1u);
            asm volatile("s_waitcnt vmcnt(0)" ::: "memory");
        } else {
            XB_SPIN(xb_ld(&bar[XB_XGEN(x)]) == gen, bar);
            __builtin_amdgcn_fence(__ATOMIC_ACQUIRE, "agent");
            asm volatile("s_waitcnt vmcnt(0)" ::: "memory");
        }
    }
    __syncthreads();
}
#define GRID_BAR() do { PH_BEGIN; grid_bar((unsigned*)ws, (volatile LAS unsigned*)(lds + LDS_BYTES - 64), (unsigned)G, tid); } while (0)
#define XN_ ((bf16_t*)(ws + WS_XN))
#define PROJ_ ((bf16_t*)(ws + WS_PROJ))

__global__ void __launch_bounds__(NTHR) hybrid_fwd(Args a_unused) {
    extern __shared__ __attribute__((aligned(16))) unsigned char lds_raw[];
    LAS unsigned char* lds = (LAS unsigned char*)lds_raw;
    cg::this_grid().sync();
    const int wave_s = __builtin_amdgcn_readfirstlane((int)threadIdx.x >> 6);
    { PH_BEGIN;
      if (tid == 0) { volatile LAS unsigned* st = (volatile LAS unsigned*)(lds + LDS_BYTES - 64); st[0] = 0u; st[1] = 0u; (void)xb_add(&((unsigned*)ws)[XB_XCNT(xb_xcc_id())], 1u); }
      __syncthreads(); }

    { PH_BEGIN;
      rope_table((float*)(ws + WS_ROPE), gtid, nthr); }
    { PH_BEGIN;
        LAS float* scr = (LAS float*)(lds + wave * 16384);
        constexpr int I_IN = (DM / 64) * (NINP / 32), I_UP = (DM / 64) * (NUP / 32), I_DN = (DFF / 64) * (DM / 32), I_B = (512 / 64) * (DM / 32), I_SQ = (DM / 64) * (DM / 32), I_PP = (PLE / 64) * (DM / 32);
        constexpr int PER_L = I_IN + I_UP + I_DN + 2 * I_B + 2 * I_SQ + I_PP;
#pragma unroll 1
        for (int it = gw; it < DEPTH * PER_L; it += ngw) {
            const int l = it / PER_L; int r = it % PER_L;
            if (r < I_IN) { transpose_item<1>(ap->in[3] + (size_t)l * DM * NIN, DM, NIN, NINP, (bf16_t*)(ws + WS_WIN + l * SZ_WIN), scr, r, lane, ap->in[2] + l * DM); continue; } r -= I_IN;
            if (r < I_UP) { transpose_item<0>(ap->in[17] + (size_t)l * DM * NUP, DM, NUP, NUP, (bf16_t*)(ws + WS_WUP + l * SZ_WUP), scr, r, lane, ap->in[16] + l * DM); continue; } r -= I_UP;
            const float* W; int K; bf16_t* WT; const float* gk = nullptr;
            if (r < I_DN) { W = ap->in[20] + (size_t)l * DFF * DM; K = DFF; WT = (bf16_t*)(ws + WS_WDN + l * SZ_WDN); }
            else { r -= I_DN;
            if (r < I_B) { W = ap->in[13] + (size_t)l * 512 * DM; K = 512; WT = (bf16_t*)(ws + WS_WBA + l * SZ_WB); }
            else { r -= I_B;
            if (r < I_B) { W = ap->in[14] + (size_t)l * 512 * DM; K = 512; WT = (bf16_t*)(ws + WS_WBB + l * SZ_WB); }
            else { r -= I_B;
            if (r < I_SQ) { W = ap->in[15] + (size_t)l * DM * DM; K = DM; WT = (bf16_t*)(ws + WS_WOUT + l * SZ_WSQ); }
            else { r -= I_SQ;
            if (r < I_SQ) { W = ap->in[22] + (size_t)l * DM * DM; K = DM; WT = (bf16_t*)(ws + WS_WPG + l * SZ_WSQ); gk = ap->in[21] + l * DM; }
            else { r -= I_SQ; W = ap->in[23] + (size_t)l * PLE * DM; K = PLE; WT = (bf16_t*)(ws + WS_WPP + l * SZ_WPP); } } } } }
            transpose_item<0>(W, K, DM, DM, WT, scr, r, lane, gk);
        }
    }
    { PH_BEGIN;
#pragma unroll 1
      for (int m = gw; m < M; m += ngw) raw_row_to_bf16(ap->in[0] + (size_t)m * DM, (bf16_t*)H + (size_t)m * DM, (float*)(ws + WS_RSTD) + m, lane); }
    GRID_BAR();

#pragma unroll 1
    for (int l = 0; l < DEPTH; ++l) {
        { PH_BEGIN; pg8::Gemm g{(const bf16_t*)H, (const bf16_t*)(ws + WS_WIN + l * SZ_WIN), M, NINP, DM, DM}; pg8::StaticOrder S; S.init(M, NINP, G, bx);
          pg8::EpiStore<0, true> E{PROJ_, NINP, (const float*)(ws + WS_RSTD)};
          pg8::gemm_phase<pg8::EpiStore<0, true>, pg8::StaticOrder, true, true>(lds, g, S, E, tid); }
        GRID_BAR();
        { PH_BEGIN; const float* rope = (const float*)(ws + WS_ROPE);
#pragma unroll 1
          for (int m = gw; m < M; m += ngw) qk_post_token(PROJ_ + (size_t)m * NINP, rope + (size_t)(m % SEQ) * 64, ap->in[4] + l * 64, ap->in[5] + l * 64, ap->in[6] + l * 64, ap->in[7] + l * 64, lane); }
        { PH_BEGIN;
#pragma unroll 1
          for (int tile = gw; tile < (M / 64) * 9; tile += ngw) vt_tile(PROJ_, (bf16_t*)(ws + WS_VTA), (bf16_t*)(ws + WS_VTB), (LAS bf16_t*)(lds + wave * 9216), tile, lane); }
        GRID_BAR();
        { PH_BEGIN;
            float* scr = (float*)(ws + WS_XN) + (size_t)bx * 32 * SEQ;
#pragma unroll 1
            for (int k = 0; vcu + (k >> 1) * G < NB * 32; ++k) { const int u = k, pr = vcu + (k >> 1) * G, b = pr >> 5, j = pr & 31;
                idx_unit<3>(PROJ_, (unsigned long long*)(ws + WS_MASK), scr, lds, b, (u & 1) ? j : 63 - j, tid, wave, lane);
                }
            __syncthreads();
        }
        { PH_BEGIN;
            const float lam_init = l == 0 ? 0.2f : 0.35550906759f;
            const float sa = wave_sum(ap->in[8][l * 64 + lane] * ap->in[9][l * 64 + lane], lane), sb = wave_sum(ap->in[10][l * 64 + lane] * ap->in[11][l * 64 + lane], lane);
            const float lam = __builtin_amdgcn_exp2f(sa * 1.4426950408889634f) - __builtin_amdgcn_exp2f(sb * 1.4426950408889634f) + lam_init;
#pragma unroll 1
            for (int k = 0; vcu + (k >> 1) * G < NB * 4 * 8; ++k) { const int u = k, pr = vcu + (k >> 1) * G, b = pr >> 5, hd = (pr >> 3) & 3, j = pr & 7;
                attn_unit<1>(PROJ_, PROJ_ + C_QB, NINP, (const bf16_t*)(ws + WS_VTB), nullptr, lds, b, hd, (u & 1) ? j : 15 - j, ap->in[12] + l * 128, lam, 1.f - lam_init, tid, wave, lane); }
        }
        __syncthreads();
        { PH_BEGIN;
#pragma unroll 1
          for (int k = 0; vcu + (k >> 1) * G < NB * 32; ++k) { const int u = k, pr = vcu + (k >> 1) * G, b = pr >> 5, j = pr & 31;
            attn_unit<0>(PROJ_, PROJ_ + C_QA, NINP, (const bf16_t*)(ws + WS_VTA), (const unsigned long long*)(ws + WS_MASK), lds, b, 0, (u & 1) ? j : 63 - j, nullptr, 0.f, 0.f, tid, wave, lane); } }
        GRID_BAR();
        { PH_BEGIN; pg8::Gemm g{PROJ_ + C_QA, (const bf16_t*)(ws + WS_WBA + l * SZ_WB), M, DM, 512, NINP}; pg8::StaticOrder S; S.init(M, DM, G, bx);
          pg8::EpiGate<false> E{(bf16_t*)(ws + WS_MIX), DM, PROJ_ + C_GA, NINP};
          pg8::gemm_phase<pg8::EpiGate<false>, pg8::StaticOrder, true, true>(lds, g, S, E, tid); }
        { PH_BEGIN; pg8::Gemm g{PROJ_ + C_QB, (const bf16_t*)(ws + WS_WBB + l * SZ_WB), M, DM, 512, NINP}; pg8::StaticOrder S; S.init(M, DM, G, bx);
          pg8::EpiGate<true> E{(bf16_t*)(ws + WS_MIX), DM, PROJ_ + C_GB, NINP};
          pg8::gemm_phase<pg8::EpiGate<true>, pg8::StaticOrder, true, true>(lds, g, S, E, tid); }
        GRID_BAR();
        { PH_BEGIN; pg8::Gemm g{(const bf16_t*)(ws + WS_MIX), (const bf16_t*)(ws + WS_WOUT + l * SZ_WSQ), M, DM, DM, DM}; pg8::StaticOrder S; S.init(M, DM, G, bx);
          pg8::EpiRes<false> E{l == 0 ? ap->in[0] : nullptr, (const bf16_t*)H, nullptr, DM, nullptr, (bf16_t*)(ws + WS_HB), (float*)(ws + WS_PSSQ)};
          pg8::gemm_phase<pg8::EpiRes<false>, pg8::StaticOrder, true, true>(lds, g, S, E, tid); }
        GRID_BAR();
        { PH_BEGIN; rstd_phase((const float*)(ws + WS_PSSQ), (float*)(ws + WS_RSTD), gtid, nthr); }
        GRID_BAR();
#pragma unroll 1
        for (int c = 0; c < 2; ++c) {
            { PH_BEGIN; pg8::Gemm g{(const bf16_t*)(ws + WS_HB) + (size_t)c * MC * DM, (const bf16_t*)(ws + WS_WUP + l * SZ_WUP), MC, NUP, DM, DM}; pg8::StaticOrder S; S.init(MC, NUP, G, bx);
              pg8::EpiStore<0, true> E{(bf16_t*)(ws + WS_UP), NUP, (const float*)(ws + WS_RSTD) + (size_t)c * MC};
              pg8::gemm_phase<pg8::EpiStore<0, true>, pg8::StaticOrder, true, true>(lds, g, S, E, tid); }
            GRID_BAR();
            { PH_BEGIN; conv_phase((const bf16_t*)(ws + WS_UP), (bf16_t*)(ws + WS_ACT) + (size_t)c * MC * DFF, ap->in[18] + (size_t)l * 3 * NUP, ap->in[19] + (size_t)l * NUP, gtid, nthr); }
            if (c == 0) { PH_BEGIN; const f32x4* ps = (const f32x4*)(ap->in[1] + (size_t)l * M * PLE); u32x2* pd = (u32x2*)(ws + WS_PB);
#pragma unroll 1
              for (int i = gtid; i < M * PLE / 4; i += nthr) { const f32x4 v = __builtin_nontemporal_load(ps + i); u32x2 o; o.x = pk2(v.x, v.y); o.y = pk2(v.z, v.w); pd[i] = o; } }
            GRID_BAR();
        }
        { PH_BEGIN; pg8::Gemm g{(const bf16_t*)(ws + WS_ACT), (const bf16_t*)(ws + WS_WDN + l * SZ_WDN), M, DM, DFF, DFF}; pg8::StaticOrder S; S.init(M, DM, G, bx);
          bf16_t* HBp = (bf16_t*)(ws + WS_HB);
          pg8::EpiRes<false> E{nullptr, HBp, nullptr, DM, nullptr, HBp, (float*)(ws + WS_PSSQ)};
          pg8::gemm_phase<pg8::EpiRes<false>, pg8::StaticOrder, true, true>(lds, g, S, E, tid); }
        GRID_BAR();
        { PH_BEGIN; rstd_phase((const float*)(ws + WS_PSSQ), (float*)(ws + WS_RSTD), gtid, nthr); }
        GRID_BAR();
        { PH_BEGIN; pg8::Gemm g{(const bf16_t*)(ws + WS_HB), (const bf16_t*)(ws + WS_WPG + l * SZ_WSQ), M, DM, DM, DM}; pg8::StaticOrder S; S.init(M, DM, G, bx);
          pg8::EpiStore<1, true> E{(bf16_t*)(ws + WS_G), DM, (const float*)(ws + WS_RSTD)};
          pg8::gemm_phase<pg8::EpiStore<1, true>, pg8::StaticOrder, true, true>(lds, g, S, E, tid); }
        { PH_BEGIN; pg8::Gemm g{(const bf16_t*)(ws + WS_PB), (const bf16_t*)(ws + WS_WPP + l * SZ_WPP), M, DM, PLE, PLE}; pg8::StaticOrder S; S.init(M, DM, G, bx);
          pg8::EpiRes<true> E{nullptr, (const bf16_t*)(ws + WS_HB), l + 1 < DEPTH ? nullptr : H, DM, (const bf16_t*)(ws + WS_G), l + 1 < DEPTH ? (bf16_t*)H : nullptr, (float*)(ws + WS_PSSQ)};
          pg8::gemm_phase<pg8::EpiRes<true>, pg8::StaticOrder, true, true>(lds, g, S, E, tid); }
        if (l + 1 < DEPTH) {
            GRID_BAR();
            { PH_BEGIN; rstd_phase((const float*)(ws + WS_PSSQ), (float*)(ws + WS_RSTD), gtid, nthr); }
            GRID_BAR();
        }
    }
}

extern "C" void kernel_launch(void* const* d_in, const int* in_sizes, int n_in, void* d_out, int out_size, void* d_ws, size_t ws_size, hipStream_t stream) {
    static int grid = 0;
    if (grid == 0) {
        if (n_in != 24 || out_size != M * DM || ws_size < WS_END2) { fprintf(stderr, "kernel_launch: unexpected sizes n_in %d out %d ws %zu (need %zu)\n", n_in, out_size, ws_size, (size_t)WS_END2); grid = -1; return; }
        int dev = 0, cus = 0, per_cu = 0;
        hipGetDevice(&dev); hipDeviceGetAttribute(&cus, hipDeviceAttributeMultiprocessorCount, dev);
        if (hipFuncSetAttribute((const void*)hybrid_fwd, hipFuncAttributeMaxDynamicSharedMemorySize, LDS_BYTES) != hipSuccess) { fprintf(stderr, "kernel_launch: hipFuncSetAttribute failed\n"); grid = -1; return; }
        if (hipOccupancyMaxActiveBlocksPerMultiprocessor(&per_cu, (const void*)hybrid_fwd, NTHR, LDS_BYTES) != hipSuccess || per_cu < 1) { fprintf(stderr, "kernel_launch: occupancy query says %d\n", per_cu); per_cu = 1; }
        (void)hipGetLastError();
        grid = cus;
    }
    if (grid < 0) return;
    if (hipMemsetAsync(d_ws, 0, 16384, stream) != hipSuccess) { fprintf(stderr, "kernel_launch: memset failed\n"); return; }
    Args a{};
    for (int i = 0; i < 24; ++i) a.in[i] = (const float*)d_in[i];
    a.out = (float*)d_out; a.ws = (unsigned char*)d_ws;
    void* args[] = {&a};
    hipError_t e = hipLaunchCooperativeKernel((const void*)hybrid_fwd, dim3(grid), dim3(NTHR), args, LDS_BYTES, stream);
    if (e != hipSuccess) fprintf(stderr, "cooperative launch failed: %s (grid %d)\n", hipGetErrorString(e), grid);
}
```

```cpp
#include <hip/hip_runtime.h>
#include <hip/hip_cooperative_groups.h>
#include <cstdio>
#include <cstdint>
namespace cg = cooperative_groups;
#define DI __device__ __forceinline__
#define LAS __attribute__((address_space(3)))
typedef float f32x2 __attribute__((ext_vector_type(2)));
typedef __bf16 bf16x2_t __attribute__((ext_vector_type(2)));
typedef float f32x16 __attribute__((ext_vector_type(16)));
typedef short s16x4 __attribute__((ext_vector_type(4)));
typedef unsigned u32x2 __attribute__((ext_vector_type(2)));
DI unsigned pk2(float a, float b) { f32x2 v = {a, b}; bf16x2_t r = __builtin_convertvector(v, bf16x2_t); return __builtin_bit_cast(unsigned, r); }
DI float bflo(unsigned w) { return __uint_as_float(w << 16); }
DI float bfhi(unsigned w) { return __uint_as_float(w & 0xffff0000u); }
DI float sigm(float x) { return __builtin_amdgcn_rcpf(1.f + __builtin_amdgcn_exp2f(-1.4426950408889634f * x)); }
namespace pg8 {
#define PG8_LAS __attribute__((address_space(3)))
typedef unsigned short bf16_t;
typedef short bf16x8 __attribute__((ext_vector_type(8)));
typedef float f32x4 __attribute__((ext_vector_type(4)));
typedef unsigned u32x4 __attribute__((ext_vector_type(4)));
constexpr int BM = 256, BK = 64, HALF = 128, HTB = HALF * BK * 2  , STAGE_BYTES = 8 * HTB, NXCD = 8, WGM = 8;

__host__ __device__ __forceinline__ int lds_byte(int r, int c) { const int st = (r >> 4) * 2 + (c >> 5), rr = r & 15, cc = c & 31, ob = rr * 64 + cc * 2; return st * 1024 + (ob ^ (((ob >> 9) & 1) << 5)); }
__host__ __device__ __forceinline__ void stage_rc(int b, int& R, int& C) { const int st = b / 1024, sb = b % 1024, swz = sb ^ (((sb >> 9) & 1) << 5); R = (st >> 1) * 16 + swz / 64; C = (st & 1) * 32 + (swz % 64) / 2; }
__host__ __device__ __forceinline__ int perm32(int rho) { const int n = rho >> 4, i = rho & 15; return 8 * (i >> 2) + 4 * n + (i & 3); }

struct Unit { int pm, pn; };
struct Gemm { const bf16_t* A; const bf16_t* Bt; int M, N, K, lda; };

struct StaticOrder {
    int nM, nN, nwg, G, c;
    __host__ __device__ void init(int M, int N, int G_, int c_) { nM = M / BM; nN = N / BM; nwg = nM * nN; G = G_; c = c_; }
    __host__ __device__ bool next(int i, Unit& u) const {
        const long L = (long)i * G + c; if (L >= nwg) return false;
        int wgid = (int)L; { const int q = nwg / NXCD, r = nwg % NXCD, xcd = wgid % NXCD, off = wgid / NXCD; wgid = (xcd < r ? xcd * (q + 1) : r * (q + 1) + (xcd - r) * q) + off; }
        const int nig = WGM * nN, gid = wgid / nig, fm = gid * WGM, gsz = (nM - fm) < WGM ? (nM - fm) : WGM;
        u.pm = fm + ((wgid % nig) % gsz); u.pn = (wgid % nig) / gsz; return true;
    }
    __device__ __forceinline__ void a_ready(const Unit&) const {}
    __device__ __forceinline__ void done(const Unit&) const {}
};

template <int ACT  , bool RS = false  > struct EpiStore {
    static constexpr bool PERM = true, AFTER_DRAIN = false;
    bf16_t* O; int ldc; const float* rs;
    __device__ __forceinline__ void operator()(const f32x4 (&acc)[2][2][4][2], const Unit& u, int wr, int wc, int fr, int fq) const {
        { int ln_; asm volatile("v_mbcnt_lo_u32_b32 %0, -1, 0\n\tv_mbcnt_hi_u32_b32 %0, -1, %0" : "=v"(ln_)); fr = ln_ & 15; fq = ln_ >> 4; }
        const int row0 = u.pm * BM + wr * 64 + fr, col0 = u.pn * BM + wc * 32 + 8 * fq;
        float rsv[2][4];
        if (RS) {
#pragma unroll
            for (int ai = 0; ai < 2; ++ai)
#pragma unroll
                for (int m = 0; m < 4; ++m) rsv[ai][m] = rs[row0 + ai * HALF + m * 16];
        }
#pragma unroll
        for (int ai = 0; ai < 2; ++ai)
#pragma unroll
            for (int m = 0; m < 4; ++m) { bf16_t* rowp = O + (size_t)(row0 + ai * HALF + m * 16) * ldc + col0;
#pragma unroll
                for (int bj = 0; bj < 2; ++bj) { f32x4 v0 = acc[ai][bj][m][0], v1 = acc[ai][bj][m][1];
                    if (RS) { v0 = v0 * rsv[ai][m]; v1 = v1 * rsv[ai][m]; }
                    if (ACT == 1) {
#pragma unroll
                        for (int e = 0; e < 4; ++e) { v0[e] = sigm(v0[e]); v1[e] = sigm(v1[e]); } }
                    u32x4 w; w.x = pk2(v0[0], v0[1]); w.y = pk2(v0[2], v0[3]); w.z = pk2(v1[0], v1[1]); w.w = pk2(v1[2], v1[3]);
                    *(u32x4*)(rowp + bj * HALF) = w; } }
    }
};
template <bool ADD> struct EpiGate {
    static constexpr bool PERM = true, AFTER_DRAIN = false;
    bf16_t* O; int ldc; const bf16_t* gate; int ldg;
    __device__ __forceinline__ void operator()(const f32x4 (&acc)[2][2][4][2], const Unit& u, int wr, int wc, int fr, int fq) const {
        { int ln_; asm volatile("v_mbcnt_lo_u32_b32 %0, -1, 0\n\tv_mbcnt_hi_u32_b32 %0, -1, %0" : "=v"(ln_)); fr = ln_ & 15; fq = ln_ >> 4; }
        const int row0 = u.pm * BM + wr * 64 + fr, col0 = u.pn * BM + wc * 32 + 8 * fq;
        constexpr int NM = 4;
#pragma unroll
        for (int ai = 0; ai < 2; ++ai)
#pragma unroll
            for (int mp = 0; mp < 4 / NM; ++mp) {
                u32x4 g[NM][2], o[NM][2];
#pragma unroll
                for (int mm = 0; mm < NM; ++mm)
#pragma unroll
                    for (int bj = 0; bj < 2; ++bj) { const size_t row = (size_t)(row0 + ai * HALF + (NM * mp + mm) * 16);
                        g[mm][bj] = *(const u32x4*)(gate + row * ldg + col0 + bj * HALF);
                        if (ADD) o[mm][bj] = *(const u32x4*)(O + row * ldc + col0 + bj * HALF); }
#pragma unroll
                for (int mm = 0; mm < NM; ++mm)
#pragma unroll
                    for (int bj = 0; bj < 2; ++bj) { const int m = NM * mp + mm; const size_t row = (size_t)(row0 + ai * HALF + m * 16);
                        const f32x4 v0 = acc[ai][bj][m][0], v1 = acc[ai][bj][m][1]; const u32x4 gg = g[mm][bj];
                        float r0 = sigm(bflo(gg.x)) * v0[0], r1 = sigm(bfhi(gg.x)) * v0[1], r2 = sigm(bflo(gg.y)) * v0[2], r3 = sigm(bfhi(gg.y)) * v0[3];
                        float r4 = sigm(bflo(gg.z)) * v1[0], r5 = sigm(bfhi(gg.z)) * v1[1], r6 = sigm(bflo(gg.w)) * v1[2], r7 = sigm(bfhi(gg.w)) * v1[3];
                        if (ADD) { const u32x4 oo = o[mm][bj];
                            r0 += bflo(oo.x); r1 += bfhi(oo.x); r2 += bflo(oo.y); r3 += bfhi(oo.y); r4 += bflo(oo.z); r5 += bfhi(oo.z); r6 += bflo(oo.w); r7 += bfhi(oo.w); }
                        u32x4 w; w.x = pk2(r0, r1); w.y = pk2(r2, r3); w.z = pk2(r4, r5); w.w = pk2(r6, r7);
                        *(u32x4*)(O + row * ldc + col0 + bj * HALF) = w; }
            }
    }
};
__device__ __forceinline__ float bperm_xor(float v, int m, int lane) { return __int_as_float(__builtin_amdgcn_ds_bpermute((lane ^ m) << 2, __float_as_int(v))); }
template <bool GMUL> struct EpiRes {
    static constexpr bool PERM = false, AFTER_DRAIN = false;
    const float* base32; const bf16_t* base16; float* out32; int ldc; const bf16_t* G; bf16_t* HB; float* PSSQ;
    template <int NM, bool B32> __device__ __forceinline__ void group(const f32x4 (&acc)[2][2][4][2], const Unit& u, int wc, int fq, int ln_, int row0, int col0, int ai, int m0) const {
        f32x4 b32[B32 ? NM : 1][2][2]; u32x2 b16[B32 ? 1 : NM][2][2]; u32x2 g[NM][2][2]; float ssq[NM];
#pragma unroll
        for (int mm = 0; mm < NM; ++mm) { ssq[mm] = 0.f;
#pragma unroll
            for (int bj = 0; bj < 2; ++bj)
#pragma unroll
                for (int n = 0; n < 2; ++n) { const size_t o2 = (size_t)(row0 + ai * HALF + (m0 + mm) * 16) * ldc + col0 + bj * HALF + n * 16;
                    if (B32) b32[mm][bj][n] = *(const f32x4*)(base32 + o2); else b16[mm][bj][n] = *(const u32x2*)(base16 + o2);
                    if (GMUL) g[mm][bj][n] = *(const u32x2*)(G + o2); } }
#pragma unroll
        for (int mm = 0; mm < NM; ++mm) {
#pragma unroll
            for (int bj = 0; bj < 2; ++bj)
#pragma unroll
                for (int n = 0; n < 2; ++n) { const int m = m0 + mm; const size_t o2 = (size_t)(row0 + ai * HALF + m * 16) * ldc + col0 + bj * HALF + n * 16;
                    f32x4 v = acc[ai][bj][m][n];
                    if (GMUL) { const u32x2 gg = g[mm][bj][n]; v[0] *= bflo(gg.x); v[1] *= bfhi(gg.x); v[2] *= bflo(gg.y); v[3] *= bfhi(gg.y); }
                    f32x4 bb;
                    if (B32) bb = b32[mm][bj][n]; else { const u32x2 t = b16[mm][bj][n]; bb = (f32x4){bflo(t.x), bfhi(t.x), bflo(t.y), bfhi(t.y)}; }
                    const f32x4 o = bb + v;
                    if (out32) *(f32x4*)(out32 + o2) = o;
                    ssq[mm] += (o[0] * o[0] + o[1] * o[1]) + (o[2] * o[2] + o[3] * o[3]);
                    if (HB) { u32x2 w; w.x = pk2(o[0], o[1]); w.y = pk2(o[2], o[3]); *(u32x2*)(HB + o2) = w; } }
            float s = ssq[mm]; s += bperm_xor(s, 16, ln_); s += bperm_xor(s, 32, ln_);
            if (fq == 0) PSSQ[(size_t)(row0 + ai * HALF + (m0 + mm) * 16) * 16 + u.pn * 4 + wc] = s;
        }
    }
    __device__ __forceinline__ void operator()(const f32x4 (&acc)[2][2][4][2], const Unit& u, int wr, int wc, int fr, int fq) const {
        int ln_; asm volatile("v_mbcnt_lo_u32_b32 %0, -1, 0\n\tv_mbcnt_hi_u32_b32 %0, -1, %0" : "=v"(ln_)); fr = ln_ & 15; fq = ln_ >> 4;
        const int row0 = u.pm * BM + wr * 64 + fr, col0 = u.pn * BM + wc * 32 + 4 * fq;
        if (base32) {
#pragma unroll
            for (int ai = 0; ai < 2; ++ai)
#pragma unroll
                for (int mp = 0; mp < 2; ++mp) group<2, true>(acc, u, wc, fq, ln_, row0, col0, ai, 2 * mp);
        } else {
#pragma unroll
            for (int ai = 0; ai < 2; ++ai) group<4, false>(acc, u, wc, fq, ln_, row0, col0, ai, 0);
        }
    }
};
template <class Epi, class Sched, bool ALIGN_EPI = false, bool SP2 = false>
__device__ __forceinline__ void gemm_phase(PG8_LAS unsigned char* lds, const Gemm g, const Sched& S, const Epi& E, const int tid_in) {
    const int tid = tid_in, wid = __builtin_amdgcn_readfirstlane(tid >> 6), lane = tid & 63, wr = wid >> 2, wc = wid & 3, fr = lane & 15, fq = lane >> 4;
    float zf_ = 0.f; asm volatile("" : "+v"(zf_));
    const int K = g.K, nt = K / BK;
    unsigned voffA[2], voffB[2];
#pragma unroll
    for (int i = 0; i < 2; ++i) { int R, C; stage_rc(tid * 16 + i * 8192, R, C); const int Rb = Epi::PERM ? ((R & ~31) + perm32(R & 31)) : R;
        voffA[i] = (unsigned)(R * g.lda + C) * 2u; voffB[i] = (unsigned)(Rb * K + C) * 2u; }
    const size_t kstep = (size_t)(BK * 2);
    const size_t hstepB = (size_t)HALF * K * 2; const size_t hstepA = (size_t)HALF * g.lda * 2;
    const size_t tstepA = 2 * hstepA; const size_t tstepB = 2 * hstepB;
    const unsigned ldsw = (unsigned)wid * 1024u;
    const int aoff = lds_byte(wr * 64 + fr, fq * 8), boff = lds_byte(wc * 32 + fr, fq * 8);
#define PG8_SA(b, h) (((b) * 2 + (h)) * HTB)
#define PG8_SB(b, h) ((4 + (b) * 2 + (h)) * HTB)
#define PG8_STAGE(bufoff, gbase, voff) do { _Pragma("unroll") for (int _i = 0; _i < 2; ++_i) \
        __builtin_amdgcn_global_load_lds((const unsigned*)((const char*)(gbase) + (voff)[_i]), (PG8_LAS unsigned*)(lds + (bufoff) + ldsw + _i * 8192), 16, 0, 0); } while (0)
#define PG8_LDA(dst, b, h) do { _Pragma("unroll") for (int m = 0; m < 4; ++m) _Pragma("unroll") for (int k = 0; k < 2; ++k) dst[m][k] = *(const PG8_LAS bf16x8*)(lds + PG8_SA(b, h) + aoff + m * 2048 + k * 1024); } while (0)
#define PG8_LDB(dst, b, h) do { _Pragma("unroll") for (int n = 0; n < 2; ++n) _Pragma("unroll") for (int k = 0; k < 2; ++k) dst[n][k] = *(const PG8_LAS bf16x8*)(lds + PG8_SB(b, h) + boff + n * 2048 + k * 1024); } while (0)
#define PG8_MMA(ai, bj, At, Bt) do { __builtin_amdgcn_s_setprio(1); _Pragma("unroll") for (int m = 0; m < 4; ++m) _Pragma("unroll") for (int n = 0; n < 2; ++n) _Pragma("unroll") for (int k = 0; k < 2; ++k) \
        acc[ai][bj][m][n] = __builtin_amdgcn_mfma_f32_16x16x32_bf16(Bt[n][k], At[m][k], acc[ai][bj][m][n], 0, 0, 0); __builtin_amdgcn_s_setprio(0); } while (0)
#define PG8_WAIT_V(n) asm volatile("s_waitcnt vmcnt(" #n ")" ::: "memory")
#define PG8_WAIT_L(n) asm volatile("s_waitcnt lgkmcnt(" #n ")" ::: "memory")
#define PG8_BAR __builtin_amdgcn_s_barrier()
#define PG8_SCHED __builtin_amdgcn_sched_barrier(0)
    Unit cur, nxt; int ui = 0;
    if (!S.next(0, cur)) return;
    f32x4 acc[2][2][4][2];
#pragma unroll
    for (int a = 0; a < 2; ++a)
#pragma unroll
        for (int b = 0; b < 2; ++b)
#pragma unroll
            for (int m = 0; m < 4; ++m)
#pragma unroll
                for (int n = 0; n < 2; ++n) acc[a][b][m][n] = (f32x4){zf_, zf_, zf_, zf_};
    bf16x8 At[4][2], B0[2][2], B1[2][2];
    const char* cA = (const char*)g.A + (size_t)cur.pm * tstepA; const char* cB = (const char*)g.Bt + (size_t)cur.pn * tstepB;
    S.a_ready(cur);
    if constexpr (SP2) {
        PG8_STAGE(PG8_SB(0, 0), cB, voffB); PG8_STAGE(PG8_SB(0, 1), cB + hstepB, voffB); PG8_STAGE(PG8_SA(0, 0), cA, voffA); PG8_STAGE(PG8_SA(0, 1), cA + hstepA, voffA);
        if (wr == 1) PG8_BAR;
        PG8_WAIT_V(2); PG8_BAR;
        PG8_STAGE(PG8_SB(1, 0), cB + kstep, voffB); PG8_STAGE(PG8_SA(1, 0), cA + kstep, voffA); PG8_STAGE(PG8_SB(1, 1), cB + hstepB + kstep, voffB);
        PG8_WAIT_V(6); PG8_BAR;
    } else {
        PG8_STAGE(PG8_SB(0, 0), cB, voffB); PG8_STAGE(PG8_SA(0, 0), cA, voffA); PG8_STAGE(PG8_SB(0, 1), cB + hstepB, voffB); PG8_STAGE(PG8_SA(0, 1), cA + hstepA, voffA);
        if (wr == 1) PG8_BAR;
        PG8_WAIT_V(4); PG8_BAR;
        PG8_STAGE(PG8_SB(1, 0), cB + kstep, voffB); PG8_STAGE(PG8_SA(1, 0), cA + kstep, voffA); PG8_STAGE(PG8_SB(1, 1), cB + hstepB + kstep, voffB);
        PG8_WAIT_V(6); PG8_BAR;
    }
    for (;;) {
        const bool has_next = S.next(ui + 1, nxt);
        const char* nA = has_next ? (const char*)g.A + (size_t)nxt.pm * tstepA : cA; const char* nB = has_next ? (const char*)g.Bt + (size_t)nxt.pn * tstepB : cB;
        for (int t = 0; t < nt; t += 2) {
            const bool last = (t == nt - 2);
            const char* a1 = cA + (size_t)(t + 1) * kstep;
            const char* a2 = last ? nA : cA + (size_t)(t + 2) * kstep; const char* b2 = last ? nB : cB + (size_t)(t + 2) * kstep;
            const char* a3 = a2 + kstep; const char* b3 = b2 + kstep;
            if (last && has_next) S.a_ready(nxt);
            if constexpr (SP2) {
            PG8_LDB(B0, 0, 0); PG8_LDB(B1, 0, 1); PG8_SCHED; PG8_LDA(At, 0, 0); PG8_STAGE(PG8_SA(1, 1), a1 + hstepA, voffA);
            PG8_WAIT_V(8); PG8_WAIT_L(0); PG8_BAR; PG8_MMA(0, 0, At, B0); PG8_MMA(0, 1, At, B1); PG8_BAR; PG8_SCHED;
            PG8_LDA(At, 0, 1); PG8_STAGE(PG8_SB(0, 0), b2, voffB); PG8_STAGE(PG8_SB(0, 1), b2 + hstepB, voffB); PG8_STAGE(PG8_SA(0, 0), a2, voffA);
            PG8_WAIT_V(8); PG8_WAIT_L(0); PG8_BAR; PG8_MMA(1, 0, At, B0); PG8_MMA(1, 1, At, B1); PG8_BAR; PG8_SCHED;
            PG8_LDB(B0, 1, 0); PG8_LDB(B1, 1, 1); PG8_SCHED; PG8_LDA(At, 1, 0); PG8_STAGE(PG8_SA(0, 1), a2 + hstepA, voffA);
            PG8_WAIT_V(8); PG8_WAIT_L(0); PG8_BAR; PG8_MMA(0, 0, At, B0); PG8_MMA(0, 1, At, B1); PG8_BAR; PG8_SCHED;
            PG8_LDA(At, 1, 1); PG8_STAGE(PG8_SB(1, 0), b3, voffB); PG8_STAGE(PG8_SB(1, 1), b3 + hstepB, voffB); PG8_STAGE(PG8_SA(1, 0), a3, voffA);
            PG8_WAIT_V(8); PG8_WAIT_L(0); PG8_BAR; PG8_MMA(1, 0, At, B0); PG8_MMA(1, 1, At, B1); PG8_BAR; PG8_SCHED;
            } else {
            PG8_LDB(B0, 0, 0); PG8_SCHED; PG8_LDA(At, 0, 0); PG8_STAGE(PG8_SA(1, 1), a1 + hstepA, voffA);
            PG8_WAIT_L(8); PG8_BAR; PG8_WAIT_L(0); PG8_MMA(0, 0, At, B0); PG8_BAR; PG8_SCHED;
            PG8_LDB(B1, 0, 1); PG8_STAGE(PG8_SB(0, 0), b2, voffB);
            PG8_BAR; PG8_WAIT_L(0); PG8_MMA(0, 1, At, B1); PG8_BAR;
            PG8_LDA(At, 0, 1); PG8_STAGE(PG8_SA(0, 0), a2, voffA);
            PG8_BAR; PG8_WAIT_L(0); PG8_MMA(1, 0, At, B0); PG8_BAR; PG8_SCHED;
            PG8_STAGE(PG8_SB(0, 1), b2 + hstepB, voffB);
            PG8_WAIT_V(6); PG8_BAR; PG8_MMA(1, 1, At, B1); PG8_BAR;
            PG8_LDB(B0, 1, 0); PG8_SCHED; PG8_LDA(At, 1, 0); PG8_STAGE(PG8_SA(0, 1), a2 + hstepA, voffA);
            PG8_WAIT_L(8); PG8_BAR; PG8_WAIT_L(0); PG8_MMA(0, 0, At, B0); PG8_BAR; PG8_SCHED;
            PG8_LDB(B1, 1, 1); PG8_STAGE(PG8_SB(1, 0), b3, voffB);
            PG8_BAR; PG8_WAIT_L(0); PG8_MMA(0, 1, At, B1); PG8_BAR;
            PG8_LDA(At, 1, 1); PG8_STAGE(PG8_SA(1, 0), a3, voffA);
            PG8_BAR; PG8_WAIT_L(0); PG8_MMA(1, 0, At, B0); PG8_BAR; PG8_SCHED;
            PG8_STAGE(PG8_SB(1, 1), b3 + hstepB, voffB);
            PG8_WAIT_V(6); PG8_BAR; PG8_MMA(1, 1, At, B1); PG8_BAR;
            }
        }
        if constexpr (ALIGN_EPI) { if (wr == 0) PG8_BAR; }
        if constexpr (!Epi::AFTER_DRAIN) { E(acc, cur, wr, wc, fr, fq); S.done(cur); }
        if (!has_next) break;
#pragma unroll
        for (int a = 0; a < 2; ++a)
#pragma unroll
            for (int b = 0; b < 2; ++b)
#pragma unroll
                for (int m = 0; m < 4; ++m)
#pragma unroll
                    for (int n = 0; n < 2; ++n) acc[a][b][m][n] = (f32x4){zf_, zf_, zf_, zf_};
        cur = nxt; cA = nA; cB = nB; ++ui;
        if constexpr (ALIGN_EPI) { if (wr == 1) PG8_BAR; }
    }
    PG8_WAIT_V(0);
    if constexpr (!ALIGN_EPI) { if (wr == 0) PG8_BAR; }
    PG8_BAR;
    if constexpr (Epi::AFTER_DRAIN) { E.fused(acc, cur, wr, wc, fr, fq, lds, wid, lane); S.done(cur); }
#undef PG8_SA
#undef PG8_SB
#undef PG8_STAGE
#undef PG8_LDA
#undef PG8_LDB
#undef PG8_MMA
#undef PG8_WAIT_V
#undef PG8_WAIT_L
#undef PG8_BAR
#undef PG8_SCHED
}
}
using pg8::bf16_t; using pg8::bf16x8; using pg8::f32x4; using pg8::u32x4;
#define MFMA32(a, b, c) __builtin_amdgcn_mfma_f32_32x32x16_bf16((a), (b), (c), 0, 0, 0)
constexpr int DM = 1024, NB = 16, SEQ = 2048, M = NB * SEQ, DEPTH = 2;
constexpr int NIN = 4548, NINP = 4608, DFF = 2816, NUP = 5632, PLE = 256;
constexpr int C_QA = 0, C_KA = 512, C_VA = 576, C_QI = 640, C_KI = 896, C_QB = 960, C_KB = 1472, C_VB = 1984, C_GA = 2496, C_GB = 3520, C_WI = 4544;
constexpr float EPS = 1e-6f;
constexpr float QSCALE = 0.125f * 1.4426950408889634f;
constexpr size_t MiB = 1u << 20;
constexpr size_t WS_ROPE = 1 * MiB;
constexpr size_t WS_WIN = 2 * MiB, SZ_WIN = (size_t)NINP * DM * 2;
constexpr size_t WS_WUP = WS_WIN + 18 * MiB, SZ_WUP = (size_t)NUP * DM * 2;
constexpr size_t WS_WDN = WS_WUP + 22 * MiB, SZ_WDN = (size_t)DM * DFF * 2;
constexpr size_t WS_WBA = WS_WDN + 11 * MiB, SZ_WB = (size_t)DM * 512 * 2;
constexpr size_t WS_WBB = WS_WBA + 2 * MiB;
constexpr size_t WS_WOUT = WS_WBB + 2 * MiB, SZ_WSQ = (size_t)DM * DM * 2;
constexpr size_t WS_WPG = WS_WOUT + 4 * MiB;
constexpr size_t WS_WPP = WS_WPG + 4 * MiB, SZ_WPP = (size_t)DM * PLE * 2;
constexpr size_t WS_PB = 66 * MiB;
constexpr size_t WS_XN = 82 * MiB;
constexpr size_t WS_PROJ = 146 * MiB;
constexpr size_t WS_VTA = 434 * MiB, WS_VTB = 438 * MiB, WS_MASK = 470 * MiB, WS_END = 478 * MiB;
constexpr size_t WS_UP = WS_PROJ, WS_ACT = WS_PROJ + 176 * MiB, WS_G = WS_PROJ;
constexpr size_t WS_HB = WS_XN;
constexpr size_t WS_HB2 = 434 * MiB;
constexpr size_t WS_MIX = 434 * MiB;
constexpr size_t WS_RSTD = 498 * MiB, WS_PSSQ = 499 * MiB, WS_END2 = 502 * MiB;
static_assert(WS_WPP + 2 * SZ_WPP <= WS_PB, "weights fit");
constexpr int MC = M / 2;
constexpr int LDS_BYTES = 147456;
constexpr int NWAVES = 8, NTHR = 512;

struct Args { const float* in[24]; float* out; unsigned char* ws; };

DI float shx(float v, int o, int lane) { return __int_as_float(__builtin_amdgcn_ds_bpermute((lane ^ o) << 2, __float_as_int(v))); }
DI float wave_sum(float v, int lane) {
#pragma unroll
    for (int o = 1; o < 64; o <<= 1) v += shx(v, o, lane);
    return v;
}
DI int crow(int i, int h) { return (i & 3) + 8 * (i >> 2) + 4 * h; }

template <int MAP> DI void transpose_item(const float* W, int K, int Nsrc, int Ndst, bf16_t* WT, LAS float* scr, int item, int lane, const float* gk = nullptr) {
    const int nblk = Ndst / 32, kb = item / nblk, nb = item % nblk, k0 = 64 * kb, n0 = 32 * nb;
    int nd = n0 + (lane & 31), ns = nd;
    if (MAP == 1) ns = nd < 960 ? nd : (nd < 4544 ? nd + 4 : (nd < 4548 ? nd - 3584 : -1));
    float wv[32];
#pragma unroll
    for (int i = 0; i < 32; ++i) { const int kk = 2 * i + (lane >> 5); wv[i] = ns >= 0 ? __builtin_nontemporal_load(W + (size_t)(k0 + kk) * Nsrc + ns) : 0.f; }
#pragma unroll
    for (int i = 0; i < 32; ++i) { const int kk = 2 * i + (lane >> 5); scr[kk * 33 + (lane & 31)] = gk ? wv[i] * gk[k0 + kk] : wv[i]; }
    asm volatile("s_waitcnt lgkmcnt(0)" ::: "memory");
    const int c = lane & 7;
#pragma unroll
    for (int j = 0; j < 4; ++j) { const int n = (lane >> 3) + 8 * j; const LAS float* s = scr + (8 * c) * 33 + n;
        u32x4 o; o.x = pk2(s[0 * 33], s[1 * 33]); o.y = pk2(s[2 * 33], s[3 * 33]); o.z = pk2(s[4 * 33], s[5 * 33]); o.w = pk2(s[6 * 33], s[7 * 33]);
        *(u32x4*)(WT + (size_t)(n0 + n) * K + k0 + 8 * c) = o; }
    asm volatile("s_waitcnt lgkmcnt(0)" ::: "memory");
}
DI void rms_row_to_bf16(const float* xrow, const float* g, bf16_t* orow, int lane) {
    const f32x4* xr = (const f32x4*)xrow + lane; const f32x4* gr = (const f32x4*)g + lane;
    f32x4 v[4]; float s = 0.f;
#pragma unroll
    for (int j = 0; j < 4; ++j) { v[j] = xr[64 * j]; s += (v[j].x * v[j].x + v[j].y * v[j].y) + (v[j].z * v[j].z + v[j].w * v[j].w); }
    const float rstd = 1.0f / sqrtf(wave_sum(s, lane) * (1.f / DM) + EPS);
    unsigned long long* o8 = (unsigned long long*)orow + lane;
#pragma unroll
    for (int j = 0; j < 4; ++j) { const f32x4 gg = gr[64 * j];
        o8[64 * j] = (unsigned long long)pk2(v[j].x * rstd * gg.x, v[j].y * rstd * gg.y) | ((unsigned long long)pk2(v[j].z * rstd * gg.z, v[j].w * rstd * gg.w) << 32); }
}
DI void raw_row_to_bf16(const float* xrow, bf16_t* orow, float* rstd_out, int lane) {
    const f32x4* xr = (const f32x4*)xrow + lane;
    f32x4 v[4]; float s = 0.f;
#pragma unroll
    for (int j = 0; j < 4; ++j) { v[j] = __builtin_nontemporal_load(xr + 64 * j); s += (v[j].x * v[j].x + v[j].y * v[j].y) + (v[j].z * v[j].z + v[j].w * v[j].w); }
    const float rstd = 1.0f / sqrtf(wave_sum(s, lane) * (1.f / DM) + EPS);
    unsigned long long* o8 = (unsigned long long*)orow + lane;
#pragma unroll
    for (int j = 0; j < 4; ++j) o8[64 * j] = (unsigned long long)pk2(v[j].x, v[j].y) | ((unsigned long long)pk2(v[j].z, v[j].w) << 32);
    if (lane == 0) *rstd_out = rstd;
}
DI void raw_rows2_to_bf16(const float* xa, const float* xb, bf16_t* oa, bf16_t* ob, float* ra, float* rb, int lane) {
    const f32x4* pa = (const f32x4*)xa + lane; const f32x4* pb = (const f32x4*)xb + lane;
    f32x4 va[4], vb[4];
#pragma unroll
    for (int j = 0; j < 4; ++j) { va[j] = __builtin_nontemporal_load(pa + 64 * j); vb[j] = __builtin_nontemporal_load(pb + 64 * j); }
    float sa = 0.f, sb = 0.f;
#pragma unroll
    for (int j = 0; j < 4; ++j) { sa += (va[j].x * va[j].x + va[j].y * va[j].y) + (va[j].z * va[j].z + va[j].w * va[j].w); sb += (vb[j].x * vb[j].x + vb[j].y * vb[j].y) + (vb[j].z * vb[j].z + vb[j].w * vb[j].w); }
    const float rsa = 1.0f / sqrtf(wave_sum(sa, lane) * (1.f / DM) + EPS), rsb = 1.0f / sqrtf(wave_sum(sb, lane) * (1.f / DM) + EPS);
    unsigned long long* qa = (unsigned long long*)oa + lane; unsigned long long* qb = (unsigned long long*)ob + lane;
#pragma unroll
    for (int j = 0; j < 4; ++j) { qa[64 * j] = (unsigned long long)pk2(va[j].x, va[j].y) | ((unsigned long long)pk2(va[j].z, va[j].w) << 32);
                                  qb[64 * j] = (unsigned long long)pk2(vb[j].x, vb[j].y) | ((unsigned long long)pk2(vb[j].z, vb[j].w) << 32); }
    if (lane == 0) { *ra = rsa; *rb = rsb; }
}
DI void rstd_phase(const float* pssq, float* rstd, int gtid, int nthr) {
    for (int row = gtid; row < M; row += nthr) { const f32x4* p = (const f32x4*)(pssq + (size_t)row * 16); const f32x4 a = p[0], b = p[1], c = p[2], d = p[3];
        const float s = ((a.x + a.y) + (a.z + a.w)) + ((b.x + b.y) + (b.z + b.w)) + ((c.x + c.y) + (c.z + c.w)) + ((d.x + d.y) + (d.z + d.w));
        rstd[row] = 1.0f / sqrtf(s * (1.f / DM) + EPS); }
}
DI void rms_phase(const float* src, const float* g, bf16_t* dst, int gw, int ngw, int lane) {
    for (int m = gw; m < M; m += ngw) rms_row_to_bf16(src + (size_t)m * DM, g, dst + (size_t)m * DM, lane);
}
DI void rope_table(float* rope, int gtid, int nthr) {
    for (int idx = gtid; idx < SEQ * 32; idx += nthr) {
        const int t = idx >> 5, i = idx & 31;
        double inv = 1.0; const double c = 0.74989420933245582730;
        for (int k = 0; k < i; ++k) inv *= c;
        const float invf = (float)inv; const float ang = (float)t * invf;
        const double x = (double)ang; const double kk = __builtin_rint(x * 0.15915494309189533577);
        double r = __builtin_fma(-kk, 6.283185307179586232, x); r = __builtin_fma(-kk, 2.4492935982947064e-16, r);
        const double r2 = r * r; double s = 1.0, co = 1.0;
#pragma unroll
        for (int n = 13; n >= 1; --n) { s = 1.0 - r2 * (1.0 / ((2.0 * n) * (2.0 * n + 1.0))) * s; co = 1.0 - r2 * (1.0 / ((2.0 * n - 1.0) * (2.0 * n))) * co; }
        s *= r;
        rope[2 * idx] = (float)co; rope[2 * idx + 1] = (float)s;
    }
}
DI void qk_post_token(bf16_t* prow, const float* rope_t, const float* g_qa, const float* g_ka, const float* g_qb, const float* g_kb, int lane) {
    const int c = lane & 7, vsub = lane >> 3;
    u32x4 w[4];
#pragma unroll
    for (int L = 0; L < 4; ++L) { const int vid = 8 * L + vsub; const int col = vid * 64 + (vid >= 9 ? 64 : 0) + 8 * c;
        w[L] = (vid < 30) ? __builtin_nontemporal_load((const u32x4*)(prow + col)) : (u32x4){0u, 0u, 0u, 0u}; }
    float cs[8], sn[8];
#pragma unroll
    for (int q = 0; q < 4; ++q) { const f32x4 t = *(const f32x4*)(rope_t + 16 * (c & 3) + 4 * q); cs[2 * q] = t.x; sn[2 * q] = t.y; cs[2 * q + 1] = t.z; sn[2 * q + 1] = t.w; }
    const float sgn = c < 4 ? -1.f : 1.f;
#pragma unroll
    for (int L = 0; L < 4; ++L) {
        const int vid = 8 * L + vsub;
        const int ty = vid < 8 ? 0 : vid == 8 ? 1 : vid < 14 ? 4 : vid < 22 ? 2 : 3;
        float x[8] = {bflo(w[L].x), bfhi(w[L].x), bflo(w[L].y), bfhi(w[L].y), bflo(w[L].z), bfhi(w[L].z), bflo(w[L].w), bfhi(w[L].w)};
        float ss = 0.f;
#pragma unroll
        for (int e = 0; e < 8; ++e) ss += x[e] * x[e];
        ss += shx(ss, 1, lane); ss += shx(ss, 2, lane); ss += shx(ss, 4, lane);
        const float* gp = ty == 0 ? g_qa : ty == 1 ? g_ka : ty == 2 ? g_qb : g_kb;
        const float rstd = ty < 4 ? 1.0f / sqrtf(ss * (1.f / 64.f) + EPS) : 1.f;
        const float sc = (ty == 0 || ty == 2) ? QSCALE : 1.f;
        const f32x4 ga = *(const f32x4*)(gp + 8 * c), gb = *(const f32x4*)(gp + 8 * c + 4);
        const float gg[8] = {ga.x, ga.y, ga.z, ga.w, gb.x, gb.y, gb.z, gb.w};
        float y[8];
#pragma unroll
        for (int e = 0; e < 8; ++e) { x[e] = ty < 4 ? x[e] * rstd * gg[e] : x[e]; }
#pragma unroll
        for (int e = 0; e < 8; ++e) { const float p = shx(x[e], 4, lane); y[e] = (x[e] * cs[e] + sgn * p * sn[e]) * sc; }
        u32x4 o; o.x = pk2(y[0], y[1]); o.y = pk2(y[2], y[3]); o.z = pk2(y[4], y[5]); o.w = pk2(y[6], y[7]);
        const int col = vid * 64 + (vid >= 9 ? 64 : 0) + 8 * c;
        if (vid < 30) *(u32x4*)(prow + col) = o;
    }
}
DI void vt_tile(const bf16_t* PROJ, bf16_t* VTA, bf16_t* VTB, LAS bf16_t* tl, int tile, int lane) {
    const int tb = tile / 9, ct = tile % 9; const int row0 = tb * 64, b = row0 / SEQ, t0 = row0 % SEQ;
    const int col0 = ct == 0 ? C_VA : C_VB + 64 * (ct - 1);
    bf16_t* dst = ct == 0 ? VTA + (size_t)b * 64 * SEQ : VTB + ((size_t)b * 512 + 64 * (ct - 1)) * SEQ;
#pragma unroll
    for (int p = 0; p < 8; ++p) { const int tok = 8 * p + (lane >> 3), ch = lane & 7;
        const u32x4 v = __builtin_nontemporal_load((const u32x4*)(PROJ + (size_t)(row0 + tok) * NINP + col0 + 8 * ch));
        LAS bf16_t* q = tl + (8 * ch) * 72 + tok;
        q[0 * 72] = (bf16_t)(v.x & 0xffff); q[1 * 72] = (bf16_t)(v.x >> 16); q[2 * 72] = (bf16_t)(v.y & 0xffff); q[3 * 72] = (bf16_t)(v.y >> 16);
        q[4 * 72] = (bf16_t)(v.z & 0xffff); q[5 * 72] = (bf16_t)(v.z >> 16); q[6 * 72] = (bf16_t)(v.w & 0xffff); q[7 * 72] = (bf16_t)(v.w >> 16); }
    asm volatile("s_waitcnt lgkmcnt(0)" ::: "memory");
#pragma unroll
    for (int p = 0; p < 8; ++p) { const int c = 8 * p + (lane >> 3), tch = lane & 7;
        const u32x4 v = *(const LAS u32x4*)(tl + c * 72 + 8 * tch);
        *(u32x4*)(dst + (size_t)c * SEQ + t0 + 8 * tch) = v; }
    asm volatile("s_waitcnt lgkmcnt(0)" ::: "memory");
}
DI float gelu_tanh(float x) { const float u = 0.7978845608028654f * (x + 0.044715f * x * x * x); return x * __builtin_amdgcn_rcpf(1.f + __builtin_amdgcn_exp2f(-2.f * 1.4426950408889634f * u)); }
DI f32x4 unpk4(u32x2 a) { return (f32x4){bflo(a.x), bfhi(a.x), bflo(a.y), bfhi(a.y)}; }
typedef float f32x8_ __attribute__((ext_vector_type(8)));
DI f32x8_ unpk8(u32x4 a) { return (f32x8_){bflo(a.x), bfhi(a.x), bflo(a.y), bfhi(a.y), bflo(a.z), bfhi(a.z), bflo(a.w), bfhi(a.w)}; }
DI f32x8_ ld8(const float* p) { const f32x4 a = *(const f32x4*)p, b = *(const f32x4*)(p + 4); return (f32x8_){a.x, a.y, a.z, a.w, b.x, b.y, b.z, b.w}; }
DI void conv_phase(const bf16_t* UP, bf16_t* ACT, const float* cw, const float* cb, int gtid, int nthr) {
    constexpr int NG = DFF / 8, RUN = 16, NTASK = (MC / RUN) * NG;
    for (int task = gtid; task < NTASK; task += nthr) {
        const int cgp = task % NG, tr = task / NG, c0 = cgp * 8, r0 = tr * RUN, tpos = r0 % SEQ;
        f32x8_ wg[3], wv[3];
#pragma unroll
        for (int j = 0; j < 3; ++j) { wg[j] = ld8(cw + (size_t)j * NUP + c0); wv[j] = ld8(cw + (size_t)j * NUP + DFF + c0); }
        const f32x8_ bg = ld8(cb + c0), bv = ld8(cb + DFF + c0);
        f32x8_ g2 = {0.f, 0.f, 0.f, 0.f, 0.f, 0.f, 0.f, 0.f}, g1 = g2, v2 = g2, v1 = g2;
        const bf16_t* up = UP + (size_t)r0 * NUP + c0;
        if (tpos != 0) {
            g2 = unpk8(*(const u32x4*)(up - 2 * (size_t)NUP)); g1 = unpk8(*(const u32x4*)(up - (size_t)NUP));
            v2 = unpk8(*(const u32x4*)(up - 2 * (size_t)NUP + DFF)); v1 = unpk8(*(const u32x4*)(up - (size_t)NUP + DFF));
        }
#pragma unroll 4
        for (int i = 0; i < RUN; ++i) {
            const f32x8_ g0 = unpk8(__builtin_nontemporal_load((const u32x4*)(up + (size_t)i * NUP))), v0 = unpk8(__builtin_nontemporal_load((const u32x4*)(up + (size_t)i * NUP + DFF)));
            const f32x8_ cg_ = bg + wg[0] * g2 + wg[1] * g1 + wg[2] * g0, cv = bv + wv[0] * v2 + wv[1] * v1 + wv[2] * v0;
            u32x4 o; o.x = pk2(gelu_tanh(cg_[0]) * cv[0], gelu_tanh(cg_[1]) * cv[1]); o.y = pk2(gelu_tanh(cg_[2]) * cv[2], gelu_tanh(cg_[3]) * cv[3]);
            o.z = pk2(gelu_tanh(cg_[4]) * cv[4], gelu_tanh(cg_[5]) * cv[5]); o.w = pk2(gelu_tanh(cg_[6]) * cv[6], gelu_tanh(cg_[7]) * cv[7]);
            __builtin_nontemporal_store(o, (u32x4*)(ACT + (size_t)(r0 + i) * DFF + c0));
            g2 = g1; g1 = g0; v2 = v1; v1 = v0;
        }
    }
}
#ifndef PROBE_ATT_VARIANT
#define PROBE_ATT_VARIANT 0
#endif
#ifndef PROBE_NBITS
#define PROBE_NBITS 1
#endif
DI int wave_count6(unsigned c) {
    int v = (int)c;
    v += __builtin_amdgcn_update_dpp(0, v, 0x111, 0xf, 0xf, false);
    v += __builtin_amdgcn_update_dpp(0, v, 0x112, 0xf, 0xf, false);
    v += __builtin_amdgcn_update_dpp(0, v, 0x114, 0xf, 0xf, false);
    v += __builtin_amdgcn_update_dpp(0, v, 0x118, 0xf, 0xf, false);
    v += __builtin_amdgcn_update_dpp(0, v, 0x142, 0xa, 0xf, false);
    v += __builtin_amdgcn_update_dpp(0, v, 0x143, 0xc, 0xf, false);
    return __builtin_amdgcn_readlane(v, 63);
}
template <int NJ, int NBITS = 32> DI void topk_row(const float* srow, int t, int lane, unsigned long long* mrow) {
    float kv[NJ];
#pragma unroll
    for (int j = 0; j < NJ; ++j) kv[j] = srow[64 * j];
#pragma unroll
    for (int g = 0; g < NJ / 8; ++g)
        asm volatile("" : "+v"(kv[8 * g]), "+v"(kv[8 * g + 1]), "+v"(kv[8 * g + 2]), "+v"(kv[8 * g + 3]), "+v"(kv[8 * g + 4]), "+v"(kv[8 * g + 5]), "+v"(kv[8 * g + 6]), "+v"(kv[8 * g + 7]));
    unsigned key[NJ];
#pragma unroll
    for (int j = 0; j < NJ; ++j) { const unsigned u = __float_as_uint(kv[j]); const unsigned mk = (u & 0x80000000u) ? ~u : (u | 0x80000000u);
        key[j] = (lane <= t - 64 * j) ? mk : 0u; }
    unsigned T = 0u;
#pragma unroll 1
    for (int bit = 31; bit >= 32 - NBITS; --bit) {
        const unsigned cand = T | (1u << bit);
        unsigned c0 = 0u;
#pragma unroll
        for (int j = 0; j < NJ; ++j) asm("v_cmp_ge_u32_e32 vcc, %1, %2\n\tv_addc_co_u32_e32 %0, vcc, 0, %0, vcc" : "+v"(c0) : "v"(key[j]), "v"(cand) : "vcc");
        const int cnt = wave_count6(c0);
        if (cnt >= 256) T = cand;
        if (cnt == 256) break;
    }
    unsigned cg = 0u, ce = 0u;
#pragma unroll
    for (int j = 0; j < NJ; ++j) { asm("v_cmp_gt_u32_e32 vcc, %1, %2\n\tv_addc_co_u32_e32 %0, vcc, 0, %0, vcc" : "+v"(cg) : "v"(key[j]), "v"(T) : "vcc");
                                   asm("v_cmp_eq_u32_e32 vcc, %1, %2\n\tv_addc_co_u32_e32 %0, vcc, 0, %0, vcc" : "+v"(ce) : "v"(key[j]), "v"(T) : "vcc"); }
    const int gt = wave_count6(cg), eq = wave_count6(ce);
    const int need = 256 - gt; int lim = SEQ;
    if (eq > need) {
        int X = 0;
#pragma unroll 1
        for (int bit = 10; bit >= 0; --bit) { const int c = X | (1 << bit); unsigned f = 0u;
#pragma unroll
            for (int j = 0; j < NJ; ++j) f += (key[j] == T && lane < c - 64 * j) ? 1u : 0u;
            if (wave_count6(f) < need) X = c; }
        lim = X + 1;
    }
    unsigned mlo = 0u, mhi = 0u;
#pragma unroll
    for (int j = 0; j < NJ; ++j) { const unsigned long long bal = __ballot(key[j] > T || (key[j] == T && lane < lim - 64 * j));
        const bool me = lane == j; mlo = me ? (unsigned)bal : mlo; mhi = me ? (unsigned)(bal >> 32) : mhi; }
    if (lane < 32) mrow[lane] = ((unsigned long long)mhi << 32) | mlo;
}

template <int PARTS> DI void idx_unit(const bf16_t* PROJ, unsigned long long* MASK64, float* scr, LAS unsigned char* lds, int b, int qb, int tid, int wave, int lane) {
    const int q0 = qb * 32;
    const size_t rowbase = (size_t)b * SEQ;
    float zf_ = 0.f; asm volatile("" : "+v"(zf_));
    if (q0 < 256) {
#pragma unroll 1
        for (int rr = 0; rr < 4; ++rr) { const int t = q0 + wave * 4 + rr;
            if (lane < 32) { const int lo = 64 * lane; const unsigned long long w = (t >= lo + 63) ? ~0ull : (t < lo ? 0ull : ((1ull << (t - lo + 1)) - 1ull)); MASK64[(rowbase + t) * 32 + lane] = w; } }
        return;
    }
    LAS float* wl = (LAS float*)lds;
    if (tid < 128) { const int q = tid >> 2, hh = tid & 3; wl[tid] = __uint_as_float((unsigned)PROJ[(rowbase + q0 + q) * NINP + C_WI + hh] << 16); }
    const int r = lane & 31, h = lane >> 5;
    constexpr int QP = 528;
    LAS unsigned char* ql = lds + 512;
#pragma unroll
    for (int p = 0; p < 2; ++p) { const int idx = tid + 512 * p, row = idx >> 5, ch = idx & 31;
        *(LAS u32x4*)(ql + row * QP + ch * 16) = *(const u32x4*)(PROJ + (rowbase + q0 + row) * NINP + C_QI + ch * 8); }
    __syncthreads();
    const int nkb = (PARTS & 1) ? q0 / 32 + 1 : 0;
    bf16x8 kfn[4];
#pragma unroll
    for (int ks = 0; ks < 4; ++ks) kfn[ks] = *(const bf16x8*)(PROJ + (rowbase + (wave < nkb ? wave : 0) * 32 + r) * NINP + C_KI + ks * 16 + h * 8);
#pragma unroll 1
    for (int kb = wave; kb < nkb; kb += 8) {
        bf16x8 kf[4];
#pragma unroll
        for (int ks = 0; ks < 4; ++ks) kf[ks] = kfn[ks];
        { const int kbn = kb + 8 < nkb ? kb + 8 : kb;
#pragma unroll
          for (int ks = 0; ks < 4; ++ks) kfn[ks] = *(const bf16x8*)(PROJ + (rowbase + kbn * 32 + r) * NINP + C_KI + ks * 16 + h * 8); }
        f32x16 sc;
#pragma unroll
        for (int i = 0; i < 16; ++i) sc[i] = zf_;
#pragma unroll
        for (int hh = 0; hh < 4; ++hh) {
            f32x16 x;
#pragma unroll
            for (int i = 0; i < 16; ++i) x[i] = zf_;
#pragma unroll
            for (int ks = 0; ks < 4; ++ks) { const bf16x8 qfr = *(const LAS bf16x8*)(ql + r * QP + hh * 128 + ks * 32 + h * 16); x = MFMA32(qfr, kf[ks], x); }
#pragma unroll
            for (int i = 0; i < 16; ++i) { const float wv = wl[crow(i, h) * 4 + hh]; sc[i] = __builtin_fmaf(wv, __builtin_fmaxf(x[i], 0.f), sc[i]); }
        }
#pragma unroll
        for (int i = 0; i < 16; ++i) scr[crow(i, h) * SEQ + kb * 32 + r] = sc[i] + 0.f;
    }
    __syncthreads();
    const int nj = (q0 + 31) / 64 + 1;
    if (PARTS & 2) {
#pragma unroll 1
        for (int rr = 0; rr < 4; ++rr) {
            const int rq = wave * 4 + rr, t = q0 + rq;
            const float* srow = scr + rq * SEQ + lane; unsigned long long* mrow = MASK64 + (rowbase + t) * 32;
            if (PARTS == 3) { if (nj <= 8) topk_row<8>(srow, t, lane, mrow); else if (nj <= 16) topk_row<16>(srow, t, lane, mrow); else if (nj <= 24) topk_row<24>(srow, t, lane, mrow); else topk_row<32>(srow, t, lane, mrow); }
            else { unsigned long long* drow = mrow + ((WS_END - WS_MASK) / 8);
                if (nj <= 8) topk_row<8, PROBE_NBITS>(srow, t, lane, drow); else if (nj <= 16) topk_row<16, PROBE_NBITS>(srow, t, lane, drow); else if (nj <= 24) topk_row<24, PROBE_NBITS>(srow, t, lane, drow); else topk_row<32, PROBE_NBITS>(srow, t, lane, drow); }
        }
    }
    __syncthreads();
}

template <int MODE, int PV = 0> DI void attn_unit(const bf16_t* PROJ, bf16_t* obase, int ldo, const bf16_t* VT, const unsigned long long* MASK64, LAS unsigned char* lds, int b, int hd, int qb,
                                      const float* gsub, float lam, float osc, int tid, int wave, int lane) {
    constexpr int NKB = MODE ? 2 : 4, NSUB = MODE ? 2 : 1, KT = 32 * NKB * NSUB;
    constexpr int DV = MODE ? 128 : 64, NDB = DV / 32;
    constexpr int KP = MODE ? 272 : 144, VP = 2 * KT + 8;
    constexpr int KBYTES = KT * KP, VBYTES = DV * VP, STAGE = KBYTES + VBYTES;
    constexpr int KCH = MODE ? 16 : 8, VCH = KT / 8;
    constexpr int NKL = KT * KCH / 512, NVL = DV * VCH / 512;
    static_assert(2 * STAGE <= LDS_BYTES - 64 && NKL >= 1 && NVL >= 1, "attention LDS stages");
    const int r = lane & 31, h = lane >> 5;
    const size_t rowbase = (size_t)b * SEQ;
    float zf_ = 0.f; asm volatile("" : "+v"(zf_));
    int q0, ntiles, qcol, kcol, koff; const bf16_t* vtbase;
    if (MODE == 0) { q0 = qb * 32; ntiles = (q0 + 31) / KT + 1; qcol = C_QA + wave * 64; kcol = C_KA; koff = 0; vtbase = VT + (size_t)b * 64 * SEQ; }
    else { const int map = wave >> 2, sub = wave & 3; q0 = qb * 128 + sub * 32; ntiles = (qb * 128 + 127) / KT + 1; qcol = C_QB + (hd * 2 + map) * 64; kcol = C_KB + hd * 128; koff = map * 128; vtbase = VT + (size_t)(b * 4 + hd) * 128 * SEQ; }
    const bf16_t* qrow = PROJ + (rowbase + q0 + r) * NINP + qcol;
    bf16x8 qf[4];
#pragma unroll
    for (int ks = 0; ks < 4; ++ks) qf[ks] = *(const bf16x8*)(qrow + ks * 16 + h * 8);
    f32x16 ot[NDB];
#pragma unroll
    for (int db = 0; db < NDB; ++db)
#pragma unroll
        for (int i = 0; i < 16; ++i) ot[db][i] = zf_;
    float nm_run = zf_, l_run = 0.f;
    u32x4 kreg[NKL], vreg[NVL];
    const bf16_t* kg[NKL]; const bf16_t* vg[NVL]; int klds[NKL], vlds[NVL];
#pragma unroll
    for (int p = 0; p < NKL; ++p) { const int idx = tid + 512 * p; const int row = idx / KCH, ch = idx % KCH;
        kg[p] = PROJ + (rowbase + row) * NINP + kcol + ch * 8; klds[p] = row * KP + ch * 16; }
#pragma unroll
    for (int p = 0; p < NVL; ++p) { const int idx = tid + 512 * p; const int d = idx / VCH, ch = idx % VCH;
        vg[p] = vtbase + (size_t)d * SEQ + ch * 8; vlds[p] = KBYTES + d * VP + ch * 16; }
#define ATT_LOAD(kt) do { _Pragma("unroll") for (int p = 0; p < NKL; ++p) kreg[p] = *(const u32x4*)(kg[p] + (size_t)(kt) * KT * NINP); \
                          _Pragma("unroll") for (int p = 0; p < NVL; ++p) vreg[p] = *(const u32x4*)(vg[p] + (kt) * KT); } while (0)
#define ATT_STORE(st) do { _Pragma("unroll") for (int p = 0; p < NKL; ++p) *(LAS u32x4*)(lds + (st) * STAGE + klds[p]) = kreg[p]; \
                           _Pragma("unroll") for (int p = 0; p < NVL; ++p) { *(LAS u32x2*)(lds + (st) * STAGE + vlds[p]) = (u32x2){vreg[p].x, vreg[p].y}; \
                                                                             *(LAS u32x2*)(lds + (st) * STAGE + vlds[p] + 8) = (u32x2){vreg[p].z, vreg[p].w}; } } while (0)
    ATT_LOAD(0); ATT_STORE(0);
    __syncthreads();
#pragma unroll 1
    for (int kt = 0; kt < ntiles; ++kt) {
        const int st = kt & 1;
        const bool more = kt + 1 < ntiles;
        if (more && PV != 1) ATT_LOAD(kt + 1);
#pragma unroll 1
        for (int sub = 0; sub < NSUB; ++sub) {
        const int key0 = kt * KT + sub * 32 * NKB;
        if ((MODE == 0 || key0 <= q0 + 31) && PV != 2) {
            unsigned long long mw[NKB / 2];
            if (MODE == 0) {
#pragma unroll
                for (int w = 0; w < NKB / 2; ++w) mw[w] = MASK64[(rowbase + q0 + r) * 32 + (key0 >> 6) + w];
            }
            f32x16 sv[NKB];
#pragma unroll
            for (int kb2 = 0; kb2 < NKB; ++kb2)
#pragma unroll
                for (int i = 0; i < 16; ++i) sv[kb2][i] = nm_run;
            const LAS unsigned char* kb_ = lds + st * STAGE + koff + sub * 32 * NKB * KP;
#pragma unroll
            for (int kh = 0; kh < 2; ++kh) {
                bf16x8 kfr[2][NKB];
#pragma unroll
                for (int k2 = 0; k2 < 2; ++k2)
#pragma unroll
                    for (int kb2 = 0; kb2 < NKB; ++kb2) kfr[k2][kb2] = *(const LAS bf16x8*)(kb_ + (32 * kb2 + r) * KP + (2 * kh + k2) * 32 + h * 16);
                if (NKB == 2) asm volatile("" : "+v"(kfr[0][0]), "+v"(kfr[0][1]), "+v"(kfr[1][0]), "+v"(kfr[1][1]));
                else asm volatile("" : "+v"(kfr[0][0]), "+v"(kfr[0][1]), "+v"(kfr[0][NKB - 2]), "+v"(kfr[0][NKB - 1]), "+v"(kfr[1][0]), "+v"(kfr[1][1]), "+v"(kfr[1][NKB - 2]), "+v"(kfr[1][NKB - 1]));
#pragma unroll
                for (int k2 = 0; k2 < 2; ++k2)
#pragma unroll
                    for (int kb2 = 0; kb2 < NKB; ++kb2) sv[kb2] = MFMA32(kfr[k2][kb2], qf[2 * kh + k2], sv[kb2]);
            }
            if (MODE == 0) {
#pragma unroll
                for (int kb2 = 0; kb2 < NKB; ++kb2) {
                    const unsigned wsel = ((kb2 & 1) ? (unsigned)(mw[kb2 >> 1] >> 32) : (unsigned)mw[kb2 >> 1]) >> (4 * h);
#pragma unroll
                    for (int i = 0; i < 16; ++i) { const int cb = (i & 3) + 8 * (i >> 2); if (!((wsel >> cb) & 1u)) sv[kb2][i] = -1e30f; }
                }
            } else if (key0 + 32 * NKB - 1 > q0) {
                const int qq = q0 + r;
#pragma unroll
                for (int kb2 = 0; kb2 < NKB; ++kb2)
#pragma unroll
                    for (int i = 0; i < 16; ++i) { if (key0 + 32 * kb2 + crow(i, h) > qq) sv[kb2][i] = -1e30f; }
            }
            float mx = -1e30f;
#pragma unroll
            for (int kb2 = 0; kb2 < NKB; ++kb2)
#pragma unroll
                for (int i = 0; i < 16; ++i) mx = __builtin_fmaxf(mx, sv[kb2][i]);
            mx = __builtin_fmaxf(mx, shx(mx, 32, lane));
            if (__ballot(mx > 8.0f)) {
                const float delta = __builtin_fmaxf(mx, 0.f);
                const float alpha = __builtin_amdgcn_exp2f(-delta);
                nm_run -= delta; l_run *= alpha;
#pragma unroll
                for (int kb2 = 0; kb2 < NKB; ++kb2)
#pragma unroll
                    for (int i = 0; i < 16; ++i) sv[kb2][i] -= delta;
#pragma unroll
                for (int db = 0; db < NDB; ++db)
#pragma unroll
                    for (int i = 0; i < 16; ++i) ot[db][i] *= alpha;
            }
            float ps = 0.f;
#pragma unroll
            for (int kb2 = 0; kb2 < NKB; ++kb2)
#pragma unroll
                for (int i = 0; i < 16; ++i) { sv[kb2][i] = __builtin_amdgcn_exp2f(sv[kb2][i]); ps += sv[kb2][i]; }
            l_run += ps;
            const LAS unsigned char* vb_ = lds + st * STAGE + KBYTES + sub * 32 * NKB * 2;
#pragma unroll
            for (int kb2 = 0; kb2 < NKB; ++kb2)
#pragma unroll
                for (int s = 0; s < 2; ++s) {
                    u32x2 vlo[NDB], vhi[NDB];
#pragma unroll
                    for (int db = 0; db < NDB; ++db) { const LAS unsigned char* vp = vb_ + (32 * db + r) * VP + (32 * kb2 + 16 * s + 4 * h) * 2;
                        vlo[db] = *(const LAS u32x2*)vp; vhi[db] = *(const LAS u32x2*)(vp + 16); }
                    u32x4 pw;
                    pw.x = pk2(sv[kb2][8 * s + 0], sv[kb2][8 * s + 1]); pw.y = pk2(sv[kb2][8 * s + 2], sv[kb2][8 * s + 3]); pw.z = pk2(sv[kb2][8 * s + 4], sv[kb2][8 * s + 5]); pw.w = pk2(sv[kb2][8 * s + 6], sv[kb2][8 * s + 7]);
                    const bf16x8 pf = __builtin_bit_cast(bf16x8, pw);
                    if (NDB == 2) asm volatile("" : "+v"(vlo[0]), "+v"(vhi[0]), "+v"(vlo[1]), "+v"(vhi[1]));
                    else asm volatile("" : "+v"(vlo[0]), "+v"(vhi[0]), "+v"(vlo[1]), "+v"(vhi[1]), "+v"(vlo[NDB - 2]), "+v"(vhi[NDB - 2]), "+v"(vlo[NDB - 1]), "+v"(vhi[NDB - 1]));
#pragma unroll
                    for (int db = 0; db < NDB; ++db) { const u32x4 vw = {vlo[db].x, vlo[db].y, vhi[db].x, vhi[db].y};
                        ot[db] = MFMA32(__builtin_bit_cast(bf16x8, vw), pf, ot[db]); }
                }
        }
        }
        if (more && PV != 1) ATT_STORE(st ^ 1);
        __syncthreads();
    }
#undef ATT_LOAD
#undef ATT_STORE
    const float l = l_run + shx(l_run, 32, lane);
    const float inv = 1.0f / l;
    if (MODE == 0) {
#pragma unroll
        for (int db = 0; db < NDB; ++db)
#pragma unroll
            for (int g = 0; g < 4; ++g) { u32x2 o; o.x = pk2(ot[db][4 * g] * inv, ot[db][4 * g + 1] * inv); o.y = pk2(ot[db][4 * g + 2] * inv, ot[db][4 * g + 3] * inv);
                *(u32x2*)(obase + (rowbase + q0 + r) * ldo + wave * 64 + 32 * db + 8 * g + 4 * h) = o; }
    } else {
        LAS float* xch = (LAS float*)lds;
        const int map = wave >> 2, sub = wave & 3;
        if (map == 1) {
#pragma unroll
            for (int db = 0; db < NDB; ++db)
#pragma unroll
                for (int i = 0; i < 16; ++i) xch[((sub * 4 + db) * 16 + i) * 64 + lane] = ot[db][i] * inv;
        }
        __syncthreads();
        if (map == 0) {
            float ss = 0.f;
#pragma unroll
            for (int db = 0; db < NDB; ++db)
#pragma unroll
                for (int i = 0; i < 16; ++i) { const float o = ot[db][i] * inv - lam * xch[((sub * 4 + db) * 16 + i) * 64 + lane]; ot[db][i] = o; ss += o * o; }
            ss += shx(ss, 32, lane);
            const float rstd = osc / sqrtf(ss * (1.f / 128.f) + EPS);
            bf16_t* orow = obase + (rowbase + q0 + r) * ldo + hd * 128;
#pragma unroll
            for (int db = 0; db < NDB; ++db)
#pragma unroll
                for (int g = 0; g < 4; ++g) { const int d = 32 * db + 8 * g + 4 * h; const f32x4 gg = *(const f32x4*)(gsub + d);
                    u32x2 o; o.x = pk2(ot[db][4 * g] * rstd * gg.x, ot[db][4 * g + 1] * rstd * gg.y); o.y = pk2(ot[db][4 * g + 2] * rstd * gg.z, ot[db][4 * g + 3] * rstd * gg.w);
                    *(u32x2*)(orow + d) = o; }
        }
        __syncthreads();
    }
}

#ifndef PROBE_NBITS
#define PROBE_NBITS 1
#endif
#ifndef PROBE_IDX_PARTS
#define PROBE_IDX_PARTS 3
#endif
#ifndef PROBE_REP
#define PROBE_REP 0
#endif
typedef const __attribute__((address_space(4))) Args CArgs;
#define PH_BEGIN \
    CArgs* ap = (CArgs*)__builtin_amdgcn_kernarg_segment_ptr(); asm volatile("" : "+s"(ap)); \
    int wv_ = wave_s; asm volatile("" : "+s"(wv_)); \
    int ln_; asm volatile("v_mbcnt_lo_u32_b32 %0, -1, 0\n\tv_mbcnt_hi_u32_b32 %0, -1, %0" : "=v"(ln_)); \
    const int wave = wv_, lane = ln_; \
    const int tid = wave * 64 + lane; \
    const int G = gridDim.x, bx = blockIdx.x; \
    const int vcu = (G % 8 == 0) ? (bx % 8) * (G / 8) + bx / 8 : bx;     \
    const int gw = bx * NWAVES + wave, ngw = G * NWAVES, gtid = bx * NTHR + tid, nthr = G * NTHR; \
    unsigned char* ws = ap->ws; float* H = ap->out; \
    (void)vcu; (void)lane; (void)gw; (void)ngw; (void)gtid; (void)nthr; (void)H; (void)ws
#define XB_TMO      128
#define XB_XCNT(j)  (256  + 64 * (j))
#define XB_XSUB(j)  (1280 + 64 * (j))
#define XB_XGEN(j)  (2304 + 64 * (j))
#define XB_TOP      3328
#define XB_TOPGEN   3392
#define XB_SPIN_CAP (1u << 20)
DI unsigned xb_ld(unsigned* p)              { return __hip_atomic_load(p, __ATOMIC_RELAXED, __HIP_MEMORY_SCOPE_AGENT); }
DI unsigned xb_add(unsigned* p, unsigned v) { return __hip_atomic_fetch_add(p, v, __ATOMIC_RELAXED, __HIP_MEMORY_SCOPE_AGENT); }
DI unsigned xb_xcc_id() { return (unsigned)__builtin_amdgcn_s_getreg((3 << 11) | 20) & 0xFu; }
#define XB_SPIN(cond, bar) do { unsigned _sp = 0; while (cond) { __builtin_amdgcn_s_sleep(1); \
    if ((++_sp & 255u) == 0u) { if (xb_ld(&(bar)[XB_TMO])) break; if (_sp > XB_SPIN_CAP) { atomicAdd(&(bar)[XB_TMO], 1u); break; } } } } while (0)
DI void xb_complete(unsigned* bar, unsigned x, unsigned G, unsigned& nloc, unsigned& nx) {
    unsigned sum, cnt, mine, sp = 0u;
    for (;;) {
        sum = 0u; cnt = 0u; mine = 0u;
#pragma unroll
        for (unsigned j = 0; j < 16; ++j) { const unsigned c = xb_ld(&bar[XB_XCNT(j)]); sum += c; cnt += (c > 0u) ? 1u : 0u; mine = (j == x) ? c : mine; }
        if (sum == G) break;
        __builtin_amdgcn_s_sleep(1);
        if ((++sp & 255u) == 0u) { if (xb_ld(&bar[XB_TMO])) break; if (sp > XB_SPIN_CAP) { atomicAdd(&bar[XB_TMO], 1u); break; } }
    }
    nloc = mine > 0u ? mine : 1u; nx = cnt > 0u ? cnt : 1u;
}
DI void grid_bar(unsigned* bar, volatile LAS unsigned* st, unsigned G, int tid) {
    asm volatile("s_waitcnt vmcnt(0)" ::: "memory");
    __syncthreads();
    if (tid == 0) {
        __builtin_amdgcn_s_waitcnt(0);
        const unsigned x = xb_xcc_id();
        unsigned nloc = st[0], nx = st[1];
        if (nloc == 0u) { xb_complete(bar, x, G, nloc, nx); st[0] = nloc; st[1] = nx; }
        const unsigned old = xb_add(&bar[XB_XSUB(x)], 1u);
        const unsigned gen = old / nloc;
        if (old + 1u == (gen + 1u) * nloc) {
            __builtin_amdgcn_fence(__ATOMIC_RELEASE, "agent");
            asm volatile("s_waitcnt vmcnt(0)" ::: "memory");
            const unsigned og = xb_add(&bar[XB_TOP], 1u);
            const unsigned tg = og / nx;
            if (og + 1u == (tg + 1u) * nx) xb_add(&bar[XB_TOPGEN], 1u);
            else XB_SPIN(xb_ld(&bar[XB_TOPGEN]) == tg, bar);
            __builtin_amdgcn_fence(__ATOMIC_ACQUIRE, "agent");
            xb_add(&bar[XB_XGEN(x)], 1u);
            asm volatile("s_waitcnt vmcnt(0)" ::: "memory");
        } else {
            XB_SPIN(xb_ld(&bar[XB_XGEN(x)]) == gen, bar);
            __builtin_amdgcn_fence(__ATOMIC_ACQUIRE, "agent");
            asm volatile("s_waitcnt vmcnt(0)" ::: "memory");
        }
    }
    __syncthreads();
}
#define GRID_BAR() do { PH_BEGIN; grid_bar((unsigned*)ws, (volatile LAS unsigned*)(lds + LDS_BYTES - 64), (unsigned)G, tid); } while (0)
#define XN_ ((bf16_t*)(ws + WS_XN))
#define PROJ_ ((bf16_t*)(ws + WS_PROJ))

__global__ void __launch_bounds__(NTHR) hybrid_fwd(Args a_unused) {
    extern __shared__ __attribute__((aligned(16))) unsigned char lds_raw[];
    LAS unsigned char* lds = (LAS unsigned char*)lds_raw;
    cg::this_grid().sync();
    const int wave_s = __builtin_amdgcn_readfirstlane((int)threadIdx.x >> 6);
    { PH_BEGIN;
      if (tid == 0) { volatile LAS unsigned* st = (volatile LAS unsigned*)(lds + LDS_BYTES - 64); st[0] = 0u; st[1] = 0u; (void)xb_add(&((unsigned*)ws)[XB_XCNT(xb_xcc_id())], 1u); }
      __syncthreads(); }

    { PH_BEGIN;
      rope_table((float*)(ws + WS_ROPE), gtid, nthr); }
    { PH_BEGIN;
        LAS float* scr = (LAS float*)(lds + wave * 16384);
        constexpr int I_IN = (DM / 64) * (NINP / 32), I_UP = (DM / 64) * (NUP / 32), I_DN = (DFF / 64) * (DM / 32), I_B = (512 / 64) * (DM / 32), I_SQ = (DM / 64) * (DM / 32), I_PP = (PLE / 64) * (DM / 32);
        constexpr int PER_L = I_IN + I_UP + I_DN + 2 * I_B + 2 * I_SQ + I_PP;
#pragma unroll 1
        for (int it = gw; it < DEPTH * PER_L; it += ngw) {
            const int l = it / PER_L; int r = it % PER_L;
            if (r < I_IN) { transpose_item<1>(ap->in[3] + (size_t)l * DM * NIN, DM, NIN, NINP, (bf16_t*)(ws + WS_WIN + l * SZ_WIN), scr, r, lane, ap->in[2] + l * DM); continue; } r -= I_IN;
            if (r < I_UP) { transpose_item<0>(ap->in[17] + (size_t)l * DM * NUP, DM, NUP, NUP, (bf16_t*)(ws + WS_WUP + l * SZ_WUP), scr, r, lane, ap->in[16] + l * DM); continue; } r -= I_UP;
            const float* W; int K; bf16_t* WT; const float* gk = nullptr;
            if (r < I_DN) { W = ap->in[20] + (size_t)l * DFF * DM; K = DFF; WT = (bf16_t*)(ws + WS_WDN + l * SZ_WDN); }
            else { r -= I_DN;
            if (r < I_B) { W = ap->in[13] + (size_t)l * 512 * DM; K = 512; WT = (bf16_t*)(ws + WS_WBA + l * SZ_WB); }
            else { r -= I_B;
            if (r < I_B) { W = ap->in[14] + (size_t)l * 512 * DM; K = 512; WT = (bf16_t*)(ws + WS_WBB + l * SZ_WB); }
            else { r -= I_B;
            if (r < I_SQ) { W = ap->in[15] + (size_t)l * DM * DM; K = DM; WT = (bf16_t*)(ws + WS_WOUT + l * SZ_WSQ); }
            else { r -= I_SQ;
            if (r < I_SQ) { W = ap->in[22] + (size_t)l * DM * DM; K = DM; WT = (bf16_t*)(ws + WS_WPG + l * SZ_WSQ); gk = ap->in[21] + l * DM; }
            else { r -= I_SQ; W = ap->in[23] + (size_t)l * PLE * DM; K = PLE; WT = (bf16_t*)(ws + WS_WPP + l * SZ_WPP); } } } } }
            transpose_item<0>(W, K, DM, DM, WT, scr, r, lane, gk);
        }
    }
    { PH_BEGIN;
#pragma unroll 1
      for (int m = gw; m < M; m += 2 * ngw) { const int m2 = m + ngw;
        if (m2 < M) raw_rows2_to_bf16(ap->in[0] + (size_t)m * DM, ap->in[0] + (size_t)m2 * DM, (bf16_t*)H + (size_t)m * DM, (bf16_t*)H + (size_t)m2 * DM, (float*)(ws + WS_RSTD) + m, (float*)(ws + WS_RSTD) + m2, lane);
        else raw_row_to_bf16(ap->in[0] + (size_t)m * DM, (bf16_t*)H + (size_t)m * DM, (float*)(ws + WS_RSTD) + m, lane); } }
    GRID_BAR();

#pragma unroll 1
    for (int l = 0; l < DEPTH; ++l) {
        { PH_BEGIN; pg8::Gemm g{(const bf16_t*)H, (const bf16_t*)(ws + WS_WIN + l * SZ_WIN), M, NINP, DM, DM}; pg8::StaticOrder S; S.init(M, NINP, G, bx);
          pg8::EpiStore<0, true> E{PROJ_, NINP, (const float*)(ws + WS_RSTD)};
          pg8::gemm_phase<pg8::EpiStore<0, true>, pg8::StaticOrder, true, true>(lds, g, S, E, tid); }
        GRID_BAR();
        { PH_BEGIN; const float* rope = (const float*)(ws + WS_ROPE);
#pragma unroll 1
          for (int m = gw; m < M; m += ngw) qk_post_token(PROJ_ + (size_t)m * NINP, rope + (size_t)(m % SEQ) * 64, ap->in[4] + l * 64, ap->in[5] + l * 64, ap->in[6] + l * 64, ap->in[7] + l * 64, lane); }
        { PH_BEGIN;
#pragma unroll 1
          for (int tile = gw; tile < (M / 64) * 9; tile += ngw) vt_tile(PROJ_, (bf16_t*)(ws + WS_VTA), (bf16_t*)(ws + WS_VTB), (LAS bf16_t*)(lds + wave * 9216), tile, lane); }
        GRID_BAR();
        { PH_BEGIN;
            float* scr = (float*)(ws + WS_XN) + (size_t)bx * 32 * SEQ;
#pragma unroll 1
            for (int k = 0; vcu + (k >> 1) * G < NB * 32; ++k) { const int u = k, pr = vcu + (k >> 1) * G, b = pr >> 5, j = pr & 31;
                idx_unit<3>(PROJ_, (unsigned long long*)(ws + WS_MASK), scr, lds, b, (u & 1) ? j : 63 - j, tid, wave, lane);
                }
            __syncthreads();
        }
        { PH_BEGIN;
            const float lam_init = l == 0 ? 0.2f : 0.35550906759f;
            const float sa = wave_sum(ap->in[8][l * 64 + lane] * ap->in[9][l * 64 + lane], lane), sb = wave_sum(ap->in[10][l * 64 + lane] * ap->in[11][l * 64 + lane], lane);
            const float lam = __builtin_amdgcn_exp2f(sa * 1.4426950408889634f) - __builtin_amdgcn_exp2f(sb * 1.4426950408889634f) + lam_init;
#pragma unroll 1
            for (int k = 0; vcu + (k >> 1) * G < NB * 4 * 8; ++k) { const int u = k, pr = vcu + (k >> 1) * G, b = pr >> 5, hd = (pr >> 3) & 3, j = pr & 7;
                attn_unit<1>(PROJ_, PROJ_ + C_QB, NINP, (const bf16_t*)(ws + WS_VTB), nullptr, lds, b, hd, (u & 1) ? j : 15 - j, ap->in[12] + l * 128, lam, 1.f - lam_init, tid, wave, lane); }
        }
        __syncthreads();
        { PH_BEGIN;
#pragma unroll 1
          for (int k = 0; vcu + (k >> 1) * G < NB * 32; ++k) { const int u = k, pr = vcu + (k >> 1) * G, b = pr >> 5, j = pr & 31;
            attn_unit<0>(PROJ_, PROJ_ + C_QA, NINP, (const bf16_t*)(ws + WS_VTA), (const unsigned long long*)(ws + WS_MASK), lds, b, 0, (u & 1) ? j : 63 - j, nullptr, 0.f, 0.f, tid, wave, lane); } }
        GRID_BAR();
        { PH_BEGIN; pg8::Gemm g{PROJ_ + C_QA, (const bf16_t*)(ws + WS_WBA + l * SZ_WB), M, DM, 512, NINP}; pg8::StaticOrder S; S.init(M, DM, G, bx);
          pg8::EpiGate<false> E{(bf16_t*)(ws + WS_MIX), DM, PROJ_ + C_GA, NINP};
          pg8::gemm_phase<pg8::EpiGate<false>, pg8::StaticOrder, true, true>(lds, g, S, E, tid); }
        { PH_BEGIN; pg8::Gemm g{PROJ_ + C_QB, (const bf16_t*)(ws + WS_WBB + l * SZ_WB), M, DM, 512, NINP}; pg8::StaticOrder S; S.init(M, DM, G, bx);
          pg8::EpiGate<true> E{(bf16_t*)(ws + WS_MIX), DM, PROJ_ + C_GB, NINP};
          pg8::gemm_phase<pg8::EpiGate<true>, pg8::StaticOrder, true, true>(lds, g, S, E, tid); }
        GRID_BAR();
        { PH_BEGIN; pg8::Gemm g{(const bf16_t*)(ws + WS_MIX), (const bf16_t*)(ws + WS_WOUT + l * SZ_WSQ), M, DM, DM, DM}; pg8::StaticOrder S; S.init(M, DM, G, bx);
          pg8::EpiRes<false> E{l == 0 ? ap->in[0] : nullptr, (const bf16_t*)H, nullptr, DM, nullptr, (bf16_t*)(ws + WS_HB), (float*)(ws + WS_PSSQ)};
          pg8::gemm_phase<pg8::EpiRes<false>, pg8::StaticOrder, true, true>(lds, g, S, E, tid); }
        GRID_BAR();
        { PH_BEGIN; rstd_phase((const float*)(ws + WS_PSSQ), (float*)(ws + WS_RSTD), gtid, nthr); }
        GRID_BAR();
#pragma unroll 1
        for (int c = 0; c < 2; ++c) {
            { PH_BEGIN; pg8::Gemm g{(const bf16_t*)(ws + WS_HB) + (size_t)c * MC * DM, (const bf16_t*)(ws + WS_WUP + l * SZ_WUP), MC, NUP, DM, DM}; pg8::StaticOrder S; S.init(MC, NUP, G, bx);
              pg8::EpiStore<0, true> E{(bf16_t*)(ws + WS_UP), NUP, (const float*)(ws + WS_RSTD) + (size_t)c * MC};
              pg8::gemm_phase<pg8::EpiStore<0, true>, pg8::StaticOrder, true, true>(lds, g, S, E, tid); }
            GRID_BAR();
            { PH_BEGIN; conv_phase((const bf16_t*)(ws + WS_UP), (bf16_t*)(ws + WS_ACT) + (size_t)c * MC * DFF, ap->in[18] + (size_t)l * 3 * NUP, ap->in[19] + (size_t)l * NUP, gtid, nthr); }
            if (c == 0) { PH_BEGIN; const f32x4* ps = (const f32x4*)(ap->in[1] + (size_t)l * M * PLE); u32x2* pd = (u32x2*)(ws + WS_PB);
#pragma unroll 1
              for (int i = gtid; i < M * PLE / 4; i += nthr) { const f32x4 v = __builtin_nontemporal_load(ps + i); u32x2 o; o.x = pk2(v.x, v.y); o.y = pk2(v.z, v.w); pd[i] = o; } }
            GRID_BAR();
        }
        { PH_BEGIN; pg8::Gemm g{(const bf16_t*)(ws + WS_ACT), (const bf16_t*)(ws + WS_WDN + l * SZ_WDN), M, DM, DFF, DFF}; pg8::StaticOrder S; S.init(M, DM, G, bx);
          bf16_t* HBp = (bf16_t*)(ws + WS_HB);
          pg8::EpiRes<false> E{nullptr, HBp, nullptr, DM, nullptr, HBp, (float*)(ws + WS_PSSQ)};
          pg8::gemm_phase<pg8::EpiRes<false>, pg8::StaticOrder, true, true>(lds, g, S, E, tid); }
        GRID_BAR();
        { PH_BEGIN; rstd_phase((const float*)(ws + WS_PSSQ), (float*)(ws + WS_RSTD), gtid, nthr); }
        GRID_BAR();
        { PH_BEGIN; pg8::Gemm g{(const bf16_t*)(ws + WS_HB), (const bf16_t*)(ws + WS_WPG + l * SZ_WSQ), M, DM, DM, DM}; pg8::StaticOrder S; S.init(M, DM, G, bx);
          pg8::EpiStore<1, true> E{(bf16_t*)(ws + WS_G), DM, (const float*)(ws + WS_RSTD)};
          pg8::gemm_phase<pg8::EpiStore<1, true>, pg8::StaticOrder, true, true>(lds, g, S, E, tid); }
        { PH_BEGIN; pg8::Gemm g{(const bf16_t*)(ws + WS_PB), (const bf16_t*)(ws + WS_WPP + l * SZ_WPP), M, DM, PLE, PLE}; pg8::StaticOrder S; S.init(M, DM, G, bx);
          pg8::EpiRes<true> E{nullptr, (const bf16_t*)(ws + WS_HB), l + 1 < DEPTH ? nullptr : H, DM, (const bf16_t*)(ws + WS_G), l + 1 < DEPTH ? (bf16_t*)H : nullptr, (float*)(ws + WS_PSSQ)};
          pg8::gemm_phase<pg8::EpiRes<true>, pg8::StaticOrder, true, true>(lds, g, S, E, tid); }
        if (l + 1 < DEPTH) {
            GRID_BAR();
            { PH_BEGIN; rstd_phase((const float*)(ws + WS_PSSQ), (float*)(ws + WS_RSTD), gtid, nthr); }
            GRID_BAR();
        }
    }
}

extern "C" void kernel_launch(void* const* d_in, const int* in_sizes, int n_in, void* d_out, int out_size, void* d_ws, size_t ws_size, hipStream_t stream) {
    static int grid = 0;
    if (grid == 0) {
        if (n_in != 24 || out_size != M * DM || ws_size < WS_END2) { fprintf(stderr, "kernel_launch: unexpected sizes n_in %d out %d ws %zu (need %zu)\n", n_in, out_size, ws_size, (size_t)WS_END2); grid = -1; return; }
        int dev = 0, cus = 0, per_cu = 0;
        hipGetDevice(&dev); hipDeviceGetAttribute(&cus, hipDeviceAttributeMultiprocessorCount, dev);
        if (hipFuncSetAttribute((const void*)hybrid_fwd, hipFuncAttributeMaxDynamicSharedMemorySize, LDS_BYTES) != hipSuccess) { fprintf(stderr, "kernel_launch: hipFuncSetAttribute failed\n"); grid = -1; return; }
        if (hipOccupancyMaxActiveBlocksPerMultiprocessor(&per_cu, (const void*)hybrid_fwd, NTHR, LDS_BYTES) != hipSuccess || per_cu < 1) { fprintf(stderr, "kernel_launch: occupancy query says %d\n", per_cu); per_cu = 1; }
        (void)hipGetLastError();
        grid = cus;
    }
    if (grid < 0) return;
    if (hipMemsetAsync(d_ws, 0, 16384, stream) != hipSuccess) { fprintf(stderr, "kernel_launch: memset failed\n"); return; }
    Args a{};
    for (int i = 0; i < 24; ++i) a.in[i] = (const float*)d_in[i];
    a.out = (float*)d_out; a.ws = (unsigned char*)d_ws;
    void* args[] = {&a};
    hipError_t e = hipLaunchCooperativeKernel((const void*)hybrid_fwd, dim3(grid), dim3(NTHR), args, LDS_BYTES, stream);
    if (e != hipSuccess) fprintf(stderr, "cooperative launch failed: %s (grid %d)\n", hipGetErrorString(e), grid);
}
```

```cpp
#include <hip/hip_runtime.h>
#include <hip/hip_cooperative_groups.h>
#include <cstdio>
#include <cstdint>
namespace cg = cooperative_groups;
#define DI __device__ __forceinline__
#define LAS __attribute__((address_space(3)))
typedef float f32x2 __attribute__((ext_vector_type(2)));
typedef __bf16 bf16x2_t __attribute__((ext_vector_type(2)));
typedef float f32x16 __attribute__((ext_vector_type(16)));
typedef short s16x4 __attribute__((ext_vector_type(4)));
typedef unsigned u32x2 __attribute__((ext_vector_type(2)));
DI unsigned pk2(float a, float b) { f32x2 v = {a, b}; bf16x2_t r = __builtin_convertvector(v, bf16x2_t); return __builtin_bit_cast(unsigned, r); }
DI float bflo(unsigned w) { return __uint_as_float(w << 16); }
DI float bfhi(unsigned w) { return __uint_as_float(w & 0xffff0000u); }
DI float sigm(float x) { return __builtin_amdgcn_rcpf(1.f + __builtin_amdgcn_exp2f(-1.4426950408889634f * x)); }
namespace pg8 {
#define PG8_LAS __attribute__((address_space(3)))
typedef unsigned short bf16_t;
typedef short bf16x8 __attribute__((ext_vector_type(8)));
typedef float f32x4 __attribute__((ext_vector_type(4)));
typedef unsigned u32x4 __attribute__((ext_vector_type(4)));
constexpr int BM = 256, BK = 64, HALF = 128, HTB = HALF * BK * 2  , STAGE_BYTES = 8 * HTB, NXCD = 8, WGM = 8;

__host__ __device__ __forceinline__ int lds_byte(int r, int c) { const int st = (r >> 4) * 2 + (c >> 5), rr = r & 15, cc = c & 31, ob = rr * 64 + cc * 2; return st * 1024 + (ob ^ (((ob >> 9) & 1) << 5)); }
__host__ __device__ __forceinline__ void stage_rc(int b, int& R, int& C) { const int st = b / 1024, sb = b % 1024, swz = sb ^ (((sb >> 9) & 1) << 5); R = (st >> 1) * 16 + swz / 64; C = (st & 1) * 32 + (swz % 64) / 2; }
__host__ __device__ __forceinline__ int perm32(int rho) { const int n = rho >> 4, i = rho & 15; return 8 * (i >> 2) + 4 * n + (i & 3); }

struct Unit { int pm, pn; };
struct Gemm { const bf16_t* A; const bf16_t* Bt; int M, N, K, lda; };

struct StaticOrder {
    int nM, nN, nwg, G, c;
    __host__ __device__ void init(int M, int N, int G_, int c_) { nM = M / BM; nN = N / BM; nwg = nM * nN; G = G_; c = c_; }
    __host__ __device__ bool next(int i, Unit& u) const {
        const long L = (long)i * G + c; if (L >= nwg) return false;
        int wgid = (int)L; { const int q = nwg / NXCD, r = nwg % NXCD, xcd = wgid % NXCD, off = wgid / NXCD; wgid = (xcd < r ? xcd * (q + 1) : r * (q + 1) + (xcd - r) * q) + off; }
        const int nig = WGM * nN, gid = wgid / nig, fm = gid * WGM, gsz = (nM - fm) < WGM ? (nM - fm) : WGM;
        u.pm = fm + ((wgid % nig) % gsz); u.pn = (wgid % nig) / gsz; return true;
    }
    __device__ __forceinline__ void a_ready(const Unit&) const {}
    __device__ __forceinline__ void done(const Unit&) const {}
};

template <int ACT  , bool RS = false  > struct EpiStore {
    static constexpr bool PERM = true, AFTER_DRAIN = false;
    bf16_t* O; int ldc; const float* rs;
    __device__ __forceinline__ void operator()(const f32x4 (&acc)[2][2][4][2], const Unit& u, int wr, int wc, int fr, int fq) const {
        { int ln_; asm volatile("v_mbcnt_lo_u32_b32 %0, -1, 0\n\tv_mbcnt_hi_u32_b32 %0, -1, %0" : "=v"(ln_)); fr = ln_ & 15; fq = ln_ >> 4; }
        const int row0 = u.pm * BM + wr * 64 + fr, col0 = u.pn * BM + wc * 32 + 8 * fq;
        float rsv[2][4];
        if (RS) {
#pragma unroll
            for (int ai = 0; ai < 2; ++ai)
#pragma unroll
                for (int m = 0; m < 4; ++m) rsv[ai][m] = rs[row0 + ai * HALF + m * 16];
        }
#pragma unroll
        for (int ai = 0; ai < 2; ++ai)
#pragma unroll
            for (int m = 0; m < 4; ++m) { bf16_t* rowp = O + (size_t)(row0 + ai * HALF + m * 16) * ldc + col0;
#pragma unroll
                for (int bj = 0; bj < 2; ++bj) { f32x4 v0 = acc[ai][bj][m][0], v1 = acc[ai][bj][m][1];
                    if (RS) { v0 = v0 * rsv[ai][m]; v1 = v1 * rsv[ai][m]; }
                    if (ACT == 1) {
#pragma unroll
                        for (int e = 0; e < 4; ++e) { v0[e] = sigm(v0[e]); v1[e] = sigm(v1[e]); } }
                    u32x4 w; w.x = pk2(v0[0], v0[1]); w.y = pk2(v0[2], v0[3]); w.z = pk2(v1[0], v1[1]); w.w = pk2(v1[2], v1[3]);
                    *(u32x4*)(rowp + bj * HALF) = w; } }
    }
};
template <bool ADD> struct EpiGate {
    static constexpr bool PERM = true, AFTER_DRAIN = false;
    bf16_t* O; int ldc; const bf16_t* gate; int ldg;
    __device__ __forceinline__ void operator()(const f32x4 (&acc)[2][2][4][2], const Unit& u, int wr, int wc, int fr, int fq) const {
        { int ln_; asm volatile("v_mbcnt_lo_u32_b32 %0, -1, 0\n\tv_mbcnt_hi_u32_b32 %0, -1, %0" : "=v"(ln_)); fr = ln_ & 15; fq = ln_ >> 4; }
        const int row0 = u.pm * BM + wr * 64 + fr, col0 = u.pn * BM + wc * 32 + 8 * fq;
        constexpr int NM = 4;
#pragma unroll
        for (int ai = 0; ai < 2; ++ai)
#pragma unroll
            for (int mp = 0; mp < 4 / NM; ++mp) {
                u32x4 g[NM][2], o[NM][2];
#pragma unroll
                for (int mm = 0; mm < NM; ++mm)
#pragma unroll
                    for (int bj = 0; bj < 2; ++bj) { const size_t row = (size_t)(row0 + ai * HALF + (NM * mp + mm) * 16);
                        g[mm][bj] = *(const u32x4*)(gate + row * ldg + col0 + bj * HALF);
                        if (ADD) o[mm][bj] = *(const u32x4*)(O + row * ldc + col0 + bj * HALF); }
#pragma unroll
                for (int mm = 0; mm < NM; ++mm)
#pragma unroll
                    for (int bj = 0; bj < 2; ++bj) { const int m = NM * mp + mm; const size_t row = (size_t)(row0 + ai * HALF + m * 16);
                        const f32x4 v0 = acc[ai][bj][m][0], v1 = acc[ai][bj][m][1]; const u32x4 gg = g[mm][bj];
                        float r0 = sigm(bflo(gg.x)) * v0[0], r1 = sigm(bfhi(gg.x)) * v0[1], r2 = sigm(bflo(gg.y)) * v0[2], r3 = sigm(bfhi(gg.y)) * v0[3];
                        float r4 = sigm(bflo(gg.z)) * v1[0], r5 = sigm(bfhi(gg.z)) * v1[1], r6 = sigm(bflo(gg.w)) * v1[2], r7 = sigm(bfhi(gg.w)) * v1[3];
                        if (ADD) { const u32x4 oo = o[mm][bj];
                            r0 += bflo(oo.x); r1 += bfhi(oo.x); r2 += bflo(oo.y); r3 += bfhi(oo.y); r4 += bflo(oo.z); r5 += bfhi(oo.z); r6 += bflo(oo.w); r7 += bfhi(oo.w); }
                        u32x4 w; w.x = pk2(r0, r1); w.y = pk2(r2, r3); w.z = pk2(r4, r5); w.w = pk2(r6, r7);
                        *(u32x4*)(O + row * ldc + col0 + bj * HALF) = w; }
            }
    }
};
__device__ __forceinline__ float bperm_xor(float v, int m, int lane) { return __int_as_float(__builtin_amdgcn_ds_bpermute((lane ^ m) << 2, __float_as_int(v))); }
template <bool GMUL> struct EpiRes {
    static constexpr bool PERM = false, AFTER_DRAIN = false;
    const float* base32; const bf16_t* base16; float* out32; int ldc; const bf16_t* G; bf16_t* HB; float* PSSQ;
    template <int NM, bool B32> __device__ __forceinline__ void group(const f32x4 (&acc)[2][2][4][2], const Unit& u, int wc, int fq, int ln_, int row0, int col0, int ai, int m0) const {
        f32x4 b32[B32 ? NM : 1][2][2]; u32x2 b16[B32 ? 1 : NM][2][2]; u32x2 g[NM][2][2]; float ssq[NM];
#pragma unroll
        for (int mm = 0; mm < NM; ++mm) { ssq[mm] = 0.f;
#pragma unroll
            for (int bj = 0; bj < 2; ++bj)
#pragma unroll
                for (int n = 0; n < 2; ++n) { const size_t o2 = (size_t)(row0 + ai * HALF + (m0 + mm) * 16) * ldc + col0 + bj * HALF + n * 16;
                    if (B32) b32[mm][bj][n] = *(const f32x4*)(base32 + o2); else b16[mm][bj][n] = *(const u32x2*)(base16 + o2);
                    if (GMUL) g[mm][bj][n] = *(const u32x2*)(G + o2); } }
#pragma unroll
        for (int mm = 0; mm < NM; ++mm) {
#pragma unroll
            for (int bj = 0; bj < 2; ++bj)
#pragma unroll
                for (int n = 0; n < 2; ++n) { const int m = m0 + mm; const size_t o2 = (size_t)(row0 + ai * HALF + m * 16) * ldc + col0 + bj * HALF + n * 16;
                    f32x4 v = acc[ai][bj][m][n];
                    if (GMUL) { const u32x2 gg = g[mm][bj][n]; v[0] *= bflo(gg.x); v[1] *= bfhi(gg.x); v[2] *= bflo(gg.y); v[3] *= bfhi(gg.y); }
                    f32x4 bb;
                    if (B32) bb = b32[mm][bj][n]; else { const u32x2 t = b16[mm][bj][n]; bb = (f32x4){bflo(t.x), bfhi(t.x), bflo(t.y), bfhi(t.y)}; }
                    const f32x4 o = bb + v;
                    if (out32) *(f32x4*)(out32 + o2) = o;
                    ssq[mm] += (o[0] * o[0] + o[1] * o[1]) + (o[2] * o[2] + o[3] * o[3]);
                    if (HB) { u32x2 w; w.x = pk2(o[0], o[1]); w.y = pk2(o[2], o[3]); *(u32x2*)(HB + o2) = w; } }
            float s = ssq[mm]; s += bperm_xor(s, 16, ln_); s += bperm_xor(s, 32, ln_);
            if (fq == 0) PSSQ[(size_t)(row0 + ai * HALF + (m0 + mm) * 16) * 16 + u.pn * 4 + wc] = s;
        }
    }
    __device__ __forceinline__ void operator()(const f32x4 (&acc)[2][2][4][2], const Unit& u, int wr, int wc, int fr, int fq) const {
        int ln_; asm volatile("v_mbcnt_lo_u32_b32 %0, -1, 0\n\tv_mbcnt_hi_u32_b32 %0, -1, %0" : "=v"(ln_)); fr = ln_ & 15; fq = ln_ >> 4;
        const int row0 = u.pm * BM + wr * 64 + fr, col0 = u.pn * BM + wc * 32 + 4 * fq;
        if (base32) {
#pragma unroll
            for (int ai = 0; ai < 2; ++ai)
#pragma unroll
                for (int mp = 0; mp < 2; ++mp) group<2, true>(acc, u, wc, fq, ln_, row0, col0, ai, 2 * mp);
        } else {
#pragma unroll
            for (int ai = 0; ai < 2; ++ai) group<4, false>(acc, u, wc, fq, ln_, row0, col0, ai, 0);
        }
    }
};
template <class Epi, class Sched, bool ALIGN_EPI = false, bool SP2 = false>
__device__ __forceinline__ void gemm_phase(PG8_LAS unsigned char* lds, const Gemm g, const Sched& S, const Epi& E, const int tid_in) {
    const int tid = tid_in, wid = __builtin_amdgcn_readfirstlane(tid >> 6), lane = tid & 63, wr = wid >> 2, wc = wid & 3, fr = lane & 15, fq = lane >> 4;
    float zf_ = 0.f; asm volatile("" : "+v"(zf_));
    const int K = g.K, nt = K / BK;
    unsigned voffA[2], voffB[2];
#pragma unroll
    for (int i = 0; i < 2; ++i) { int R, C; stage_rc(tid * 16 + i * 8192, R, C); const int Rb = Epi::PERM ? ((R & ~31) + perm32(R & 31)) : R;
        voffA[i] = (unsigned)(R * g.lda + C) * 2u; voffB[i] = (unsigned)(Rb * K + C) * 2u; }
    const size_t kstep = (size_t)(BK * 2);
    const size_t hstepB = (size_t)HALF * K * 2; const size_t hstepA = (size_t)HALF * g.lda * 2;
    const size_t tstepA = 2 * hstepA; const size_t tstepB = 2 * hstepB;
    const unsigned ldsw = (unsigned)wid * 1024u;
    const int aoff = lds_byte(wr * 64 + fr, fq * 8), boff = lds_byte(wc * 32 + fr, fq * 8);
#define PG8_SA(b, h) (((b) * 2 + (h)) * HTB)
#define PG8_SB(b, h) ((4 + (b) * 2 + (h)) * HTB)
#define PG8_STAGE(bufoff, gbase, voff) do { _Pragma("unroll") for (int _i = 0; _i < 2; ++_i) \
        __builtin_amdgcn_global_load_lds((const unsigned*)((const char*)(gbase) + (voff)[_i]), (PG8_LAS unsigned*)(lds + (bufoff) + ldsw + _i * 8192), 16, 0, 0); } while (0)
#define PG8_LDA(dst, b, h) do { _Pragma("unroll") for (int m = 0; m < 4; ++m) _Pragma("unroll") for (int k = 0; k < 2; ++k) dst[m][k] = *(const PG8_LAS bf16x8*)(lds + PG8_SA(b, h) + aoff + m * 2048 + k * 1024); } while (0)
#define PG8_LDB(dst, b, h) do { _Pragma("unroll") for (int n = 0; n < 2; ++n) _Pragma("unroll") for (int k = 0; k < 2; ++k) dst[n][k] = *(const PG8_LAS bf16x8*)(lds + PG8_SB(b, h) + boff + n * 2048 + k * 1024); } while (0)
#define PG8_MMA(ai, bj, At, Bt) do { __builtin_amdgcn_s_setprio(1); _Pragma("unroll") for (int m = 0; m < 4; ++m) _Pragma("unroll") for (int n = 0; n < 2; ++n) _Pragma("unroll") for (int k = 0; k < 2; ++k) \
        acc[ai][bj][m][n] = __builtin_amdgcn_mfma_f32_16x16x32_bf16(Bt[n][k], At[m][k], acc[ai][bj][m][n], 0, 0, 0); __builtin_amdgcn_s_setprio(0); } while (0)
#define PG8_WAIT_V(n) asm volatile("s_waitcnt vmcnt(" #n ")" ::: "memory")
#define PG8_WAIT_L(n) asm volatile("s_waitcnt lgkmcnt(" #n ")" ::: "memory")
#define PG8_BAR __builtin_amdgcn_s_barrier()
#define PG8_SCHED __builtin_amdgcn_sched_barrier(0)
    Unit cur, nxt; int ui = 0;
    if (!S.next(0, cur)) return;
    f32x4 acc[2][2][4][2];
#pragma unroll
    for (int a = 0; a < 2; ++a)
#pragma unroll
        for (int b = 0; b < 2; ++b)
#pragma unroll
            for (int m = 0; m < 4; ++m)
#pragma unroll
                for (int n = 0; n < 2; ++n) acc[a][b][m][n] = (f32x4){zf_, zf_, zf_, zf_};
    bf16x8 At[4][2], B0[2][2], B1[2][2];
    const char* cA = (const char*)g.A + (size_t)cur.pm * tstepA; const char* cB = (const char*)g.Bt + (size_t)cur.pn * tstepB;
    S.a_ready(cur);
    if constexpr (SP2) {
        PG8_STAGE(PG8_SB(0, 0), cB, voffB); PG8_STAGE(PG8_SB(0, 1), cB + hstepB, voffB); PG8_STAGE(PG8_SA(0, 0), cA, voffA); PG8_STAGE(PG8_SA(0, 1), cA + hstepA, voffA);
        if (wr == 1) PG8_BAR;
        PG8_WAIT_V(2); PG8_BAR;
        PG8_STAGE(PG8_SB(1, 0), cB + kstep, voffB); PG8_STAGE(PG8_SA(1, 0), cA + kstep, voffA); PG8_STAGE(PG8_SB(1, 1), cB + hstepB + kstep, voffB);
        PG8_WAIT_V(6); PG8_BAR;
    } else {
        PG8_STAGE(PG8_SB(0, 0), cB, voffB); PG8_STAGE(PG8_SA(0, 0), cA, voffA); PG8_STAGE(PG8_SB(0, 1), cB + hstepB, voffB); PG8_STAGE(PG8_SA(0, 1), cA + hstepA, voffA);
        if (wr == 1) PG8_BAR;
        PG8_WAIT_V(4); PG8_BAR;
        PG8_STAGE(PG8_SB(1, 0), cB + kstep, voffB); PG8_STAGE(PG8_SA(1, 0), cA + kstep, voffA); PG8_STAGE(PG8_SB(1, 1), cB + hstepB + kstep, voffB);
        PG8_WAIT_V(6); PG8_BAR;
    }
    for (;;) {
        const bool has_next = S.next(ui + 1, nxt);
        const char* nA = has_next ? (const char*)g.A + (size_t)nxt.pm * tstepA : cA; const char* nB = has_next ? (const char*)g.Bt + (size_t)nxt.pn * tstepB : cB;
        for (int t = 0; t < nt; t += 2) {
            const bool last = (t == nt - 2);
            const char* a1 = cA + (size_t)(t + 1) * kstep;
            const char* a2 = last ? nA : cA + (size_t)(t + 2) * kstep; const char* b2 = last ? nB : cB + (size_t)(t + 2) * kstep;
            const char* a3 = a2 + kstep; const char* b3 = b2 + kstep;
            if (last && has_next) S.a_ready(nxt);
            if constexpr (SP2) {
            PG8_LDB(B0, 0, 0); PG8_LDB(B1, 0, 1); PG8_SCHED; PG8_LDA(At, 0, 0); PG8_STAGE(PG8_SA(1, 1), a1 + hstepA, voffA);
            PG8_WAIT_V(8); PG8_WAIT_L(0); PG8_BAR; PG8_MMA(0, 0, At, B0); PG8_MMA(0, 1, At, B1); PG8_BAR; PG8_SCHED;
            PG8_LDA(At, 0, 1); PG8_STAGE(PG8_SB(0, 0), b2, voffB); PG8_STAGE(PG8_SB(0, 1), b2 + hstepB, voffB); PG8_STAGE(PG8_SA(0, 0), a2, voffA);
            PG8_WAIT_V(8); PG8_WAIT_L(0); PG8_BAR; PG8_MMA(1, 0, At, B0); PG8_MMA(1, 1, At, B1); PG8_BAR; PG8_SCHED;
            PG8_LDB(B0, 1, 0); PG8_LDB(B1, 1, 1); PG8_SCHED; PG8_LDA(At, 1, 0); PG8_STAGE(PG8_SA(0, 1), a2 + hstepA, voffA);
            PG8_WAIT_V(8); PG8_WAIT_L(0); PG8_BAR; PG8_MMA(0, 0, At, B0); PG8_MMA(0, 1, At, B1); PG8_BAR; PG8_SCHED;
            PG8_LDA(At, 1, 1); PG8_STAGE(PG8_SB(1, 0), b3, voffB); PG8_STAGE(PG8_SB(1, 1), b3 + hstepB, voffB); PG8_STAGE(PG8_SA(1, 0), a3, voffA);
            PG8_WAIT_V(8); PG8_WAIT_L(0); PG8_BAR; PG8_MMA(1, 0, At, B0); PG8_MMA(1, 1, At, B1); PG8_BAR; PG8_SCHED;
            } else {
            PG8_LDB(B0, 0, 0); PG8_SCHED; PG8_LDA(At, 0, 0); PG8_STAGE(PG8_SA(1, 1), a1 + hstepA, voffA);
            PG8_WAIT_L(8); PG8_BAR; PG8_WAIT_L(0); PG8_MMA(0, 0, At, B0); PG8_BAR; PG8_SCHED;
            PG8_LDB(B1, 0, 1); PG8_STAGE(PG8_SB(0, 0), b2, voffB);
            PG8_BAR; PG8_WAIT_L(0); PG8_MMA(0, 1, At, B1); PG8_BAR;
            PG8_LDA(At, 0, 1); PG8_STAGE(PG8_SA(0, 0), a2, voffA);
            PG8_BAR; PG8_WAIT_L(0); PG8_MMA(1, 0, At, B0); PG8_BAR; PG8_SCHED;
            PG8_STAGE(PG8_SB(0, 1), b2 + hstepB, voffB);
            PG8_WAIT_V(6); PG8_BAR; PG8_MMA(1, 1, At, B1); PG8_BAR;
            PG8_LDB(B0, 1, 0); PG8_SCHED; PG8_LDA(At, 1, 0); PG8_STAGE(PG8_SA(0, 1), a2 + hstepA, voffA);
            PG8_WAIT_L(8); PG8_BAR; PG8_WAIT_L(0); PG8_MMA(0, 0, At, B0); PG8_BAR; PG8_SCHED;
            PG8_LDB(B1, 1, 1); PG8_STAGE(PG8_SB(1, 0), b3, voffB);
            PG8_BAR; PG8_WAIT_L(0); PG8_MMA(0, 1, At, B1); PG8_BAR;
            PG8_LDA(At, 1, 1); PG8_STAGE(PG8_SA(1, 0), a3, voffA);
            PG8_BAR; PG8_WAIT_L(0); PG8_MMA(1, 0, At, B0); PG8_BAR; PG8_SCHED;
            PG8_STAGE(PG8_SB(1, 1), b3 + hstepB, voffB);
            PG8_WAIT_V(6); PG8_BAR; PG8_MMA(1, 1, At, B1); PG8_BAR;
            }
        }
        if constexpr (ALIGN_EPI) { if (wr == 0) PG8_BAR; }
        if constexpr (!Epi::AFTER_DRAIN) { E(acc, cur, wr, wc, fr, fq); S.done(cur); }
        if (!has_next) break;
#pragma unroll
        for (int a = 0; a < 2; ++a)
#pragma unroll
            for (int b = 0; b < 2; ++b)
#pragma unroll
                for (int m = 0; m < 4; ++m)
#pragma unroll
                    for (int n = 0; n < 2; ++n) acc[a][b][m][n] = (f32x4){zf_, zf_, zf_, zf_};
        cur = nxt; cA = nA; cB = nB; ++ui;
        if constexpr (ALIGN_EPI) { if (wr == 1) PG8_BAR; }
    }
    PG8_WAIT_V(0);
    if constexpr (!ALIGN_EPI) { if (wr == 0) PG8_BAR; }
    PG8_BAR;
    if constexpr (Epi::AFTER_DRAIN) { E.fused(acc, cur, wr, wc, fr, fq, lds, wid, lane); S.done(cur); }
#undef PG8_SA
#undef PG8_SB
#undef PG8_STAGE
#undef PG8_LDA
#undef PG8_LDB
#undef PG8_MMA
#undef PG8_WAIT_V
#undef PG8_WAIT_L
#undef PG8_BAR
#undef PG8_SCHED
}
}
using pg8::bf16_t; using pg8::bf16x8; using pg8::f32x4; using pg8::u32x4;
#define MFMA32(a, b, c) __builtin_amdgcn_mfma_f32_32x32x16_bf16((a), (b), (c), 0, 0, 0)
constexpr int DM = 1024, NB = 16, SEQ = 2048, M = NB * SEQ, DEPTH = 2;
constexpr int NIN = 4548, NINP = 4608, DFF = 2816, NUP = 5632, PLE = 256;
constexpr int C_QA = 0, C_KA = 512, C_VA = 576, C_QI = 640, C_KI = 896, C_QB = 960, C_KB = 1472, C_VB = 1984, C_GA = 2496, C_GB = 3520, C_WI = 4544;
constexpr float EPS = 1e-6f;
constexpr float QSCALE = 0.125f * 1.4426950408889634f;
constexpr size_t MiB = 1u << 20;
constexpr size_t WS_ROPE = 1 * MiB;
constexpr size_t WS_WIN = 2 * MiB, SZ_WIN = (size_t)NINP * DM * 2;
constexpr size_t WS_WUP = WS_WIN + 18 * MiB, SZ_WUP = (size_t)NUP * DM * 2;
constexpr size_t WS_WDN = WS_WUP + 22 * MiB, SZ_WDN = (size_t)DM * DFF * 2;
constexpr size_t WS_WBA = WS_WDN + 11 * MiB, SZ_WB = (size_t)DM * 512 * 2;
constexpr size_t WS_WBB = WS_WBA + 2 * MiB;
constexpr size_t WS_WOUT = WS_WBB + 2 * MiB, SZ_WSQ = (size_t)DM * DM * 2;
constexpr size_t WS_WPG = WS_WOUT + 4 * MiB;
constexpr size_t WS_WPP = WS_WPG + 4 * MiB, SZ_WPP = (size_t)DM * PLE * 2;
constexpr size_t WS_PB = 66 * MiB;
constexpr size_t WS_XN = 82 * MiB;
constexpr size_t WS_PROJ = 146 * MiB;
constexpr size_t WS_VTA = 434 * MiB, WS_VTB = 438 * MiB, WS_MASK = 470 * MiB, WS_END = 478 * MiB;
constexpr size_t WS_UP = WS_PROJ, WS_ACT = WS_PROJ + 176 * MiB, WS_G = WS_PROJ;
constexpr size_t WS_HB = WS_XN;
constexpr size_t WS_HB2 = 434 * MiB;
constexpr size_t WS_MIX = 434 * MiB;
constexpr size_t WS_RSTD = 498 * MiB, WS_PSSQ = 499 * MiB, WS_END2 = 502 * MiB;
static_assert(WS_WPP + 2 * SZ_WPP <= WS_PB, "weights fit");
constexpr int MC = M / 2;
constexpr int LDS_BYTES = 147456;
constexpr int NWAVES = 8, NTHR = 512;

struct Args { const float* in[24]; float* out; unsigned char* ws; };

DI float shx(float v, int o, int lane) { return __int_as_float(__builtin_amdgcn_ds_bpermute((lane ^ o) << 2, __float_as_int(v))); }
DI float wave_sum(float v, int lane) {
#pragma unroll
    for (int o = 1; o < 64; o <<= 1) v += shx(v, o, lane);
    return v;
}
DI int crow(int i, int h) { return (i & 3) + 8 * (i >> 2) + 4 * h; }

template <int MAP> DI void transpose_item(const float* W, int K, int Nsrc, int Ndst, bf16_t* WT, LAS float* scr, int item, int lane, const float* gk = nullptr) {
    const int nblk = Ndst / 32, kb = item / nblk, nb = item % nblk, k0 = 64 * kb, n0 = 32 * nb;
    int nd = n0 + (lane & 31), ns = nd;
    if (MAP == 1) ns = nd < 960 ? nd : (nd < 4544 ? nd + 4 : (nd < 4548 ? nd - 3584 : -1));
    float wv[32];
#pragma unroll
    for (int i = 0; i < 32; ++i) { const int kk = 2 * i + (lane >> 5); wv[i] = ns >= 0 ? __builtin_nontemporal_load(W + (size_t)(k0 + kk) * Nsrc + ns) : 0.f; }
#pragma unroll
    for (int i = 0; i < 32; ++i) { const int kk = 2 * i + (lane >> 5); scr[kk * 33 + (lane & 31)] = gk ? wv[i] * gk[k0 + kk] : wv[i]; }
    asm volatile("s_waitcnt lgkmcnt(0)" ::: "memory");
    const int c = lane & 7;
#pragma unroll
    for (int j = 0; j < 4; ++j) { const int n = (lane >> 3) + 8 * j; const LAS float* s = scr + (8 * c) * 33 + n;
        u32x4 o; o.x = pk2(s[0 * 33], s[1 * 33]); o.y = pk2(s[2 * 33], s[3 * 33]); o.z = pk2(s[4 * 33], s[5 * 33]); o.w = pk2(s[6 * 33], s[7 * 33]);
        *(u32x4*)(WT + (size_t)(n0 + n) * K + k0 + 8 * c) = o; }
    asm volatile("s_waitcnt lgkmcnt(0)" ::: "memory");
}
DI void rms_row_to_bf16(const float* xrow, const float* g, bf16_t* orow, int lane) {
    const f32x4* xr = (const f32x4*)xrow + lane; const f32x4* gr = (const f32x4*)g + lane;
    f32x4 v[4]; float s = 0.f;
#pragma unroll
    for (int j = 0; j < 4; ++j) { v[j] = xr[64 * j]; s += (v[j].x * v[j].x + v[j].y * v[j].y) + (v[j].z * v[j].z + v[j].w * v[j].w); }
    const float rstd = 1.0f / sqrtf(wave_sum(s, lane) * (1.f / DM) + EPS);
    unsigned long long* o8 = (unsigned long long*)orow + lane;
#pragma unroll
    for (int j = 0; j < 4; ++j) { const f32x4 gg = gr[64 * j];
        o8[64 * j] = (unsigned long long)pk2(v[j].x * rstd * gg.x, v[j].y * rstd * gg.y) | ((unsigned long long)pk2(v[j].z * rstd * gg.z, v[j].w * rstd * gg.w) << 32); }
}
DI void raw_row_to_bf16(const float* xrow, bf16_t* orow, float* rstd_out, int lane) {
    const f32x4* xr = (const f32x4*)xrow + lane;
    f32x4 v[4]; float s = 0.f;
#pragma unroll
    for (int j = 0; j < 4; ++j) { v[j] = __builtin_nontemporal_load(xr + 64 * j); s += (v[j].x * v[j].x + v[j].y * v[j].y) + (v[j].z * v[j].z + v[j].w * v[j].w); }
    const float rstd = 1.0f / sqrtf(wave_sum(s, lane) * (1.f / DM) + EPS);
    unsigned long long* o8 = (unsigned long long*)orow + lane;
#pragma unroll
    for (int j = 0; j < 4; ++j) o8[64 * j] = (unsigned long long)pk2(v[j].x, v[j].y) | ((unsigned long long)pk2(v[j].z, v[j].w) << 32);
    if (lane == 0) *rstd_out = rstd;
}
DI void raw_rows2_to_bf16(const float* xa, const float* xb, bf16_t* oa, bf16_t* ob, float* ra, float* rb, int lane) {
    const f32x4* pa = (const f32x4*)xa + lane; const f32x4* pb = (const f32x4*)xb + lane;
    f32x4 va[4], vb[4];
#pragma unroll
    for (int j = 0; j < 4; ++j) { va[j] = __builtin_nontemporal_load(pa + 64 * j); vb[j] = __builtin_nontemporal_load(pb + 64 * j); }
    float sa = 0.f, sb = 0.f;
#pragma unroll
    for (int j = 0; j < 4; ++j) { sa += (va[j].x * va[j].x + va[j].y * va[j].y) + (va[j].z * va[j].z + va[j].w * va[j].w); sb += (vb[j].x * vb[j].x + vb[j].y * vb[j].y) + (vb[j].z * vb[j].z + vb[j].w * vb[j].w); }
    const float rsa = 1.0f / sqrtf(wave_sum(sa, lane) * (1.f / DM) + EPS), rsb = 1.0f / sqrtf(wave_sum(sb, lane) * (1.f / DM) + EPS);
    unsigned long long* qa = (unsigned long long*)oa + lane; unsigned long long* qb = (unsigned long long*)ob + lane;
#pragma unroll
    for (int j = 0; j < 4; ++j) { qa[64 * j] = (unsigned long long)pk2(va[j].x, va[j].y) | ((unsigned long long)pk2(va[j].z, va[j].w) << 32);
                                  qb[64 * j] = (unsigned long long)pk2(vb[j].x, vb[j].y) | ((unsigned long long)pk2(vb[j].z, vb[j].w) << 32); }
    if (lane == 0) { *ra = rsa; *rb = rsb; }
}
DI void rstd_phase(const float* pssq, float* rstd, int gtid, int nthr) {
    for (int row = gtid; row < M; row += nthr) { const f32x4* p = (const f32x4*)(pssq + (size_t)row * 16); const f32x4 a = p[0], b = p[1], c = p[2], d = p[3];
        const float s = ((a.x + a.y) + (a.z + a.w)) + ((b.x + b.y) + (b.z + b.w)) + ((c.x + c.y) + (c.z + c.w)) + ((d.x + d.y) + (d.z + d.w));
        rstd[row] = 1.0f / sqrtf(s * (1.f / DM) + EPS); }
}
DI void rms_phase(const float* src, const float* g, bf16_t* dst, int gw, int ngw, int lane) {
    for (int m = gw; m < M; m += ngw) rms_row_to_bf16(src + (size_t)m * DM, g, dst + (size_t)m * DM, lane);
}
DI void rope_table(float* rope, int gtid, int nthr) {
    for (int idx = gtid; idx < SEQ * 32; idx += nthr) {
        const int t = idx >> 5, i = idx & 31;
        double inv = 1.0; const double c = 0.74989420933245582730;
        for (int k = 0; k < i; ++k) inv *= c;
        const float invf = (float)inv; const float ang = (float)t * invf;
        const double x = (double)ang; const double kk = __builtin_rint(x * 0.15915494309189533577);
        double r = __builtin_fma(-kk, 6.283185307179586232, x); r = __builtin_fma(-kk, 2.4492935982947064e-16, r);
        const double r2 = r * r; double s = 1.0, co = 1.0;
#pragma unroll
        for (int n = 13; n >= 1; --n) { s = 1.0 - r2 * (1.0 / ((2.0 * n) * (2.0 * n + 1.0))) * s; co = 1.0 - r2 * (1.0 / ((2.0 * n - 1.0) * (2.0 * n))) * co; }
        s *= r;
        rope[2 * idx] = (float)co; rope[2 * idx + 1] = (float)s;
    }
}
DI void qk_post_token(bf16_t* prow, const float* rope_t, const float* g_qa, const float* g_ka, const float* g_qb, const float* g_kb, int lane) {
    const int c = lane & 7, vsub = lane >> 3;
    u32x4 w[4];
#pragma unroll
    for (int L = 0; L < 4; ++L) { const int vid = 8 * L + vsub; const int col = vid * 64 + (vid >= 9 ? 64 : 0) + 8 * c;
        w[L] = (vid < 30) ? __builtin_nontemporal_load((const u32x4*)(prow + col)) : (u32x4){0u, 0u, 0u, 0u}; }
    float cs[8], sn[8];
#pragma unroll
    for (int q = 0; q < 4; ++q) { const f32x4 t = *(const f32x4*)(rope_t + 16 * (c & 3) + 4 * q); cs[2 * q] = t.x; sn[2 * q] = t.y; cs[2 * q + 1] = t.z; sn[2 * q + 1] = t.w; }
    const float sgn = c < 4 ? -1.f : 1.f;
#pragma unroll
    for (int L = 0; L < 4; ++L) {
        const int vid = 8 * L + vsub;
        const int ty = vid < 8 ? 0 : vid == 8 ? 1 : vid < 14 ? 4 : vid < 22 ? 2 : 3;
        float x[8] = {bflo(w[L].x), bfhi(w[L].x), bflo(w[L].y), bfhi(w[L].y), bflo(w[L].z), bfhi(w[L].z), bflo(w[L].w), bfhi(w[L].w)};
        float ss = 0.f;
#pragma unroll
        for (int e = 0; e < 8; ++e) ss += x[e] * x[e];
        ss += shx(ss, 1, lane); ss += shx(ss, 2, lane); ss += shx(ss, 4, lane);
        const float* gp = ty == 0 ? g_qa : ty == 1 ? g_ka : ty == 2 ? g_qb : g_kb;
        const float rstd = ty < 4 ? 1.0f / sqrtf(ss * (1.f / 64.f) + EPS) : 1.f;
        const float sc = (ty == 0 || ty == 2) ? QSCALE : 1.f;
        const f32x4 ga = *(const f32x4*)(gp + 8 * c), gb = *(const f32x4*)(gp + 8 * c + 4);
        const float gg[8] = {ga.x, ga.y, ga.z, ga.w, gb.x, gb.y, gb.z, gb.w};
        float y[8];
#pragma unroll
        for (int e = 0; e < 8; ++e) { x[e] = ty < 4 ? x[e] * rstd * gg[e] : x[e]; }
#pragma unroll
        for (int e = 0; e < 8; ++e) { const float p = shx(x[e], 4, lane); y[e] = (x[e] * cs[e] + sgn * p * sn[e]) * sc; }
        u32x4 o; o.x = pk2(y[0], y[1]); o.y = pk2(y[2], y[3]); o.z = pk2(y[4], y[5]); o.w = pk2(y[6], y[7]);
        const int col = vid * 64 + (vid >= 9 ? 64 : 0) + 8 * c;
        if (vid < 30) *(u32x4*)(prow + col) = o;
    }
}
DI void vt_tile(const bf16_t* PROJ, bf16_t* VTA, bf16_t* VTB, LAS bf16_t* tl, int tile, int lane) {
    const int tb = tile / 9, ct = tile % 9; const int row0 = tb * 64, b = row0 / SEQ, t0 = row0 % SEQ;
    const int col0 = ct == 0 ? C_VA : C_VB + 64 * (ct - 1);
    bf16_t* dst = ct == 0 ? VTA + (size_t)b * 64 * SEQ : VTB + ((size_t)b * 512 + 64 * (ct - 1)) * SEQ;
#pragma unroll
    for (int p = 0; p < 8; ++p) { const int tok = 8 * p + (lane >> 3), ch = lane & 7;
        const u32x4 v = __builtin_nontemporal_load((const u32x4*)(PROJ + (size_t)(row0 + tok) * NINP + col0 + 8 * ch));
        LAS bf16_t* q = tl + (8 * ch) * 72 + tok;
        q[0 * 72] = (bf16_t)(v.x & 0xffff); q[1 * 72] = (bf16_t)(v.x >> 16); q[2 * 72] = (bf16_t)(v.y & 0xffff); q[3 * 72] = (bf16_t)(v.y >> 16);
        q[4 * 72] = (bf16_t)(v.z & 0xffff); q[5 * 72] = (bf16_t)(v.z >> 16); q[6 * 72] = (bf16_t)(v.w & 0xffff); q[7 * 72] = (bf16_t)(v.w >> 16); }
    asm volatile("s_waitcnt lgkmcnt(0)" ::: "memory");
#pragma unroll
    for (int p = 0; p < 8; ++p) { const int c = 8 * p + (lane >> 3), tch = lane & 7;
        const u32x4 v = *(const LAS u32x4*)(tl + c * 72 + 8 * tch);
        *(u32x4*)(dst + (size_t)c * SEQ + t0 + 8 * tch) = v; }
    asm volatile("s_waitcnt lgkmcnt(0)" ::: "memory");
}
DI float gelu_tanh(float x) { const float u = 0.7978845608028654f * (x + 0.044715f * x * x * x); return x * __builtin_amdgcn_rcpf(1.f + __builtin_amdgcn_exp2f(-2.f * 1.4426950408889634f * u)); }
DI f32x4 unpk4(u32x2 a) { return (f32x4){bflo(a.x), bfhi(a.x), bflo(a.y), bfhi(a.y)}; }
typedef float f32x8_ __attribute__((ext_vector_type(8)));
DI f32x8_ unpk8(u32x4 a) { return (f32x8_){bflo(a.x), bfhi(a.x), bflo(a.y), bfhi(a.y), bflo(a.z), bfhi(a.z), bflo(a.w), bfhi(a.w)}; }
DI f32x8_ ld8(const float* p) { const f32x4 a = *(const f32x4*)p, b = *(const f32x4*)(p + 4); return (f32x8_){a.x, a.y, a.z, a.w, b.x, b.y, b.z, b.w}; }
DI void conv_phase(const bf16_t* UP, bf16_t* ACT, const float* cw, const float* cb, int gtid, int nthr) {
    constexpr int NG = DFF / 8, RUN = 16, NTASK = (MC / RUN) * NG;
    for (int task = gtid; task < NTASK; task += nthr) {
        const int cgp = task % NG, tr = task / NG, c0 = cgp * 8, r0 = tr * RUN, tpos = r0 % SEQ;
        f32x8_ wg[3], wv[3];
#pragma unroll
        for (int j = 0; j < 3; ++j) { wg[j] = ld8(cw + (size_t)j * NUP + c0); wv[j] = ld8(cw + (size_t)j * NUP + DFF + c0); }
        const f32x8_ bg = ld8(cb + c0), bv = ld8(cb + DFF + c0);
        f32x8_ g2 = {0.f, 0.f, 0.f, 0.f, 0.f, 0.f, 0.f, 0.f}, g1 = g2, v2 = g2, v1 = g2;
        const bf16_t* up = UP + (size_t)r0 * NUP + c0;
        if (tpos != 0) {
            g2 = unpk8(*(const u32x4*)(up - 2 * (size_t)NUP)); g1 = unpk8(*(const u32x4*)(up - (size_t)NUP));
            v2 = unpk8(*(const u32x4*)(up - 2 * (size_t)NUP + DFF)); v1 = unpk8(*(const u32x4*)(up - (size_t)NUP + DFF));
        }
#pragma unroll 4
        for (int i = 0; i < RUN; ++i) {
            const f32x8_ g0 = unpk8(__builtin_nontemporal_load((const u32x4*)(up + (size_t)i * NUP))), v0 = unpk8(__builtin_nontemporal_load((const u32x4*)(up + (size_t)i * NUP + DFF)));
            const f32x8_ cg_ = bg + wg[0] * g2 + wg[1] * g1 + wg[2] * g0, cv = bv + wv[0] * v2 + wv[1] * v1 + wv[2] * v0;
            u32x4 o; o.x = pk2(gelu_tanh(cg_[0]) * cv[0], gelu_tanh(cg_[1]) * cv[1]); o.y = pk2(gelu_tanh(cg_[2]) * cv[2], gelu_tanh(cg_[3]) * cv[3]);
            o.z = pk2(gelu_tanh(cg_[4]) * cv[4], gelu_tanh(cg_[5]) * cv[5]); o.w = pk2(gelu_tanh(cg_[6]) * cv[6], gelu_tanh(cg_[7]) * cv[7]);
            __builtin_nontemporal_store(o, (u32x4*)(ACT + (size_t)(r0 + i) * DFF + c0));
            g2 = g1; g1 = g0; v2 = v1; v1 = v0;
        }
    }
}
#ifndef PROBE_ATT_VARIANT
#define PROBE_ATT_VARIANT 0
#endif
#ifndef PROBE_NBITS
#define PROBE_NBITS 1
#endif
DI int wave_count6(unsigned c) {
    int v = (int)c;
    v += __builtin_amdgcn_update_dpp(0, v, 0x111, 0xf, 0xf, false);
    v += __builtin_amdgcn_update_dpp(0, v, 0x112, 0xf, 0xf, false);
    v += __builtin_amdgcn_update_dpp(0, v, 0x114, 0xf, 0xf, false);
    v += __builtin_amdgcn_update_dpp(0, v, 0x118, 0xf, 0xf, false);
    v += __builtin_amdgcn_update_dpp(0, v, 0x142, 0xa, 0xf, false);
    v += __builtin_amdgcn_update_dpp(0, v, 0x143, 0xc, 0xf, false);
    return __builtin_amdgcn_readlane(v, 63);
}
template <int NJ, int NBITS = 32> DI void topk_row(const float* srow, int t, int lane, unsigned long long* mrow) {
    float kv[NJ];
#pragma unroll
    for (int j = 0; j < NJ; ++j) kv[j] = srow[64 * j];
#pragma unroll
    for (int g = 0; g < NJ / 8; ++g)
        asm volatile("" : "+v"(kv[8 * g]), "+v"(kv[8 * g + 1]), "+v"(kv[8 * g + 2]), "+v"(kv[8 * g + 3]), "+v"(kv[8 * g + 4]), "+v"(kv[8 * g + 5]), "+v"(kv[8 * g + 6]), "+v"(kv[8 * g + 7]));
    unsigned key[NJ];
#pragma unroll
    for (int j = 0; j < NJ; ++j) { const unsigned u = __float_as_uint(kv[j]); const unsigned mk = (u & 0x80000000u) ? ~u : (u | 0x80000000u);
        key[j] = (lane <= t - 64 * j) ? mk : 0u; }
    unsigned T = 0u;
#pragma unroll 1
    for (int bit = 31; bit >= 32 - NBITS; --bit) {
        const unsigned cand = T | (1u << bit);
        unsigned c0 = 0u;
#pragma unroll
        for (int j = 0; j < NJ; ++j) asm("v_cmp_ge_u32_e32 vcc, %1, %2\n\tv_addc_co_u32_e32 %0, vcc, 0, %0, vcc" : "+v"(c0) : "v"(key[j]), "v"(cand) : "vcc");
        const int cnt = wave_count6(c0);
        if (cnt >= 256) T = cand;
        if (cnt == 256) break;
    }
    unsigned cg = 0u, ce = 0u;
#pragma unroll
    for (int j = 0; j < NJ; ++j) { asm("v_cmp_gt_u32_e32 vcc, %1, %2\n\tv_addc_co_u32_e32 %0, vcc, 0, %0, vcc" : "+v"(cg) : "v"(key[j]), "v"(T) : "vcc");
                                   asm("v_cmp_eq_u32_e32 vcc, %1, %2\n\tv_addc_co_u32_e32 %0, vcc, 0, %0, vcc" : "+v"(ce) : "v"(key[j]), "v"(T) : "vcc"); }
    const int gt = wave_count6(cg), eq = wave_count6(ce);
    const int need = 256 - gt; int lim = SEQ;
    if (eq > need) {
        int X = 0;
#pragma unroll 1
        for (int bit = 10; bit >= 0; --bit) { const int c = X | (1 << bit); unsigned f = 0u;
#pragma unroll
            for (int j = 0; j < NJ; ++j) f += (key[j] == T && lane < c - 64 * j) ? 1u : 0u;
            if (wave_count6(f) < need) X = c; }
        lim = X + 1;
    }
    unsigned mlo = 0u, mhi = 0u;
#pragma unroll
    for (int j = 0; j < NJ; ++j) { const unsigned long long bal = __ballot(key[j] > T || (key[j] == T && lane < lim - 64 * j));
        const bool me = lane == j; mlo = me ? (unsigned)bal : mlo; mhi = me ? (unsigned)(bal >> 32) : mhi; }
    if (lane < 32) mrow[lane] = ((unsigned long long)mhi << 32) | mlo;
}

template <int PARTS> DI void idx_unit(const bf16_t* PROJ, unsigned long long* MASK64, float* scr, LAS unsigned char* lds, int b, int qb, int tid, int wave, int lane) {
    const int q0 = qb * 32;
    const size_t rowbase = (size_t)b * SEQ;
    float zf_ = 0.f; asm volatile("" : "+v"(zf_));
    if (q0 < 256) {
#pragma unroll 1
        for (int rr = 0; rr < 4; ++rr) { const int t = q0 + wave * 4 + rr;
            if (lane < 32) { const int lo = 64 * lane; const unsigned long long w = (t >= lo + 63) ? ~0ull : (t < lo ? 0ull : ((1ull << (t - lo + 1)) - 1ull)); MASK64[(rowbase + t) * 32 + lane] = w; } }
        return;
    }
    LAS float* wl = (LAS float*)lds;
    if (tid < 128) { const int q = tid >> 2, hh = tid & 3; wl[tid] = __uint_as_float((unsigned)PROJ[(rowbase + q0 + q) * NINP + C_WI + hh] << 16); }
    const int r = lane & 31, h = lane >> 5;
    constexpr int QP = 528;
    LAS unsigned char* ql = lds + 512;
#pragma unroll
    for (int p = 0; p < 2; ++p) { const int idx = tid + 512 * p, row = idx >> 5, ch = idx & 31;
        *(LAS u32x4*)(ql + row * QP + ch * 16) = *(const u32x4*)(PROJ + (rowbase + q0 + row) * NINP + C_QI + ch * 8); }
    __syncthreads();
    const int nkb = (PARTS & 1) ? q0 / 32 + 1 : 0;
    bf16x8 kfn[4];
#pragma unroll
    for (int ks = 0; ks < 4; ++ks) kfn[ks] = *(const bf16x8*)(PROJ + (rowbase + (wave < nkb ? wave : 0) * 32 + r) * NINP + C_KI + ks * 16 + h * 8);
#pragma unroll 1
    for (int kb = wave; kb < nkb; kb += 8) {
        bf16x8 kf[4];
#pragma unroll
        for (int ks = 0; ks < 4; ++ks) kf[ks] = kfn[ks];
        { const int kbn = kb + 8 < nkb ? kb + 8 : kb;
#pragma unroll
          for (int ks = 0; ks < 4; ++ks) kfn[ks] = *(const bf16x8*)(PROJ + (rowbase + kbn * 32 + r) * NINP + C_KI + ks * 16 + h * 8); }
        f32x16 sc;
#pragma unroll
        for (int i = 0; i < 16; ++i) sc[i] = zf_;
#pragma unroll
        for (int hh = 0; hh < 4; ++hh) {
            f32x16 x;
#pragma unroll
            for (int i = 0; i < 16; ++i) x[i] = zf_;
#pragma unroll
            for (int ks = 0; ks < 4; ++ks) { const bf16x8 qfr = *(const LAS bf16x8*)(ql + r * QP + hh * 128 + ks * 32 + h * 16); x = MFMA32(qfr, kf[ks], x); }
#pragma unroll
            for (int i = 0; i < 16; ++i) { const float wv = wl[crow(i, h) * 4 + hh]; sc[i] = __builtin_fmaf(wv, __builtin_fmaxf(x[i], 0.f), sc[i]); }
        }
#pragma unroll
        for (int i = 0; i < 16; ++i) scr[crow(i, h) * SEQ + kb * 32 + r] = sc[i] + 0.f;
    }
    __syncthreads();
    const int nj = (q0 + 31) / 64 + 1;
    if (PARTS & 2) {
#pragma unroll 1
        for (int rr = 0; rr < 4; ++rr) {
            const int rq = wave * 4 + rr, t = q0 + rq;
            const float* srow = scr + rq * SEQ + lane; unsigned long long* mrow = MASK64 + (rowbase + t) * 32;
            if (PARTS == 3) { if (nj <= 8) topk_row<8>(srow, t, lane, mrow); else if (nj <= 16) topk_row<16>(srow, t, lane, mrow); else if (nj <= 24) topk_row<24>(srow, t, lane, mrow); else topk_row<32>(srow, t, lane, mrow); }
            else { unsigned long long* drow = mrow + ((WS_END - WS_MASK) / 8);
                if (nj <= 8) topk_row<8, PROBE_NBITS>(srow, t, lane, drow); else if (nj <= 16) topk_row<16, PROBE_NBITS>(srow, t, lane, drow); else if (nj <= 24) topk_row<24, PROBE_NBITS>(srow, t, lane, drow); else topk_row<32, PROBE_NBITS>(srow, t, lane, drow); }
        }
    }
    __syncthreads();
}

template <int MODE, int PV = 0> DI void attn_unit(const bf16_t* PROJ, bf16_t* obase, int ldo, const bf16_t* VT, const unsigned long long* MASK64, LAS unsigned char* lds, int b, int hd, int qb,
                                      const float* gsub, float lam, float osc, int tid, int wave, int lane) {
    constexpr int NKB = MODE ? 2 : 4, NSUB = MODE ? 2 : 1, KT = 32 * NKB * NSUB;
    constexpr int DV = MODE ? 128 : 64, NDB = DV / 32;
    constexpr int KP = MODE ? 272 : 144, VP = 2 * KT + 8;
    constexpr int KBYTES = KT * KP, VBYTES = DV * VP, STAGE = KBYTES + VBYTES;
    constexpr int KCH = MODE ? 16 : 8, VCH = KT / 8;
    constexpr int NKL = KT * KCH / 512, NVL = DV * VCH / 512;
    static_assert(2 * STAGE <= LDS_BYTES - 64 && NKL >= 1 && NVL >= 1, "attention LDS stages");
    const int r = lane & 31, h = lane >> 5;
    const size_t rowbase = (size_t)b * SEQ;
    float zf_ = 0.f; asm volatile("" : "+v"(zf_));
    int q0, ntiles, qcol, kcol, koff; const bf16_t* vtbase;
    if (MODE == 0) { q0 = qb * 32; ntiles = (q0 + 31) / KT + 1; qcol = C_QA + wave * 64; kcol = C_KA; koff = 0; vtbase = VT + (size_t)b * 64 * SEQ; }
    else { const int map = wave >> 2, sub = wave & 3; q0 = qb * 128 + sub * 32; ntiles = (qb * 128 + 127) / KT + 1; qcol = C_QB + (hd * 2 + map) * 64; kcol = C_KB + hd * 128; koff = map * 128; vtbase = VT + (size_t)(b * 4 + hd) * 128 * SEQ; }
    const bf16_t* qrow = PROJ + (rowbase + q0 + r) * NINP + qcol;
    bf16x8 qf[4];
#pragma unroll
    for (int ks = 0; ks < 4; ++ks) qf[ks] = *(const bf16x8*)(qrow + ks * 16 + h * 8);
    f32x16 ot[NDB];
#pragma unroll
    for (int db = 0; db < NDB; ++db)
#pragma unroll
        for (int i = 0; i < 16; ++i) ot[db][i] = zf_;
    float nm_run = zf_, l_run = 0.f;
    u32x4 kreg[NKL], vreg[NVL];
    const bf16_t* kg[NKL]; const bf16_t* vg[NVL]; int klds[NKL], vlds[NVL];
#pragma unroll
    for (int p = 0; p < NKL; ++p) { const int idx = tid + 512 * p; const int row = idx / KCH, ch = idx % KCH;
        kg[p] = PROJ + (rowbase + row) * NINP + kcol + ch * 8; klds[p] = row * KP + ch * 16; }
#pragma unroll
    for (int p = 0; p < NVL; ++p) { const int idx = tid + 512 * p; const int d = idx / VCH, ch = idx % VCH;
        vg[p] = vtbase + (size_t)d * SEQ + ch * 8; vlds[p] = KBYTES + d * VP + ch * 16; }
#define ATT_LOAD(kt) do { _Pragma("unroll") for (int p = 0; p < NKL; ++p) kreg[p] = *(const u32x4*)(kg[p] + (size_t)(kt) * KT * NINP); \
                          _Pragma("unroll") for (int p = 0; p < NVL; ++p) vreg[p] = *(const u32x4*)(vg[p] + (kt) * KT); } while (0)
#define ATT_STORE(st) do { _Pragma("unroll") for (int p = 0; p < NKL; ++p) *(LAS u32x4*)(lds + (st) * STAGE + klds[p]) = kreg[p]; \
                           _Pragma("unroll") for (int p = 0; p < NVL; ++p) { *(LAS u32x2*)(lds + (st) * STAGE + vlds[p]) = (u32x2){vreg[p].x, vreg[p].y}; \
                                                                             *(LAS u32x2*)(lds + (st) * STAGE + vlds[p] + 8) = (u32x2){vreg[p].z, vreg[p].w}; } } while (0)
    ATT_LOAD(0); ATT_STORE(0);
    __syncthreads();
#pragma unroll 1
    for (int kt = 0; kt < ntiles; ++kt) {
        const int st = kt & 1;
        const bool more = kt + 1 < ntiles;
        if (more && PV != 1) ATT_LOAD(kt + 1);
#pragma unroll 1
        for (int sub = 0; sub < NSUB; ++sub) {
        const int key0 = kt * KT + sub * 32 * NKB;
        if ((MODE == 0 || key0 <= q0 + 31) && PV != 2) {
            unsigned long long mw[NKB / 2];
            if (MODE == 0) {
#pragma unroll
                for (int w = 0; w < NKB / 2; ++w) mw[w] = MASK64[(rowbase + q0 + r) * 32 + (key0 >> 6) + w];
            }
            f32x16 sv[NKB];
#pragma unroll
            for (int kb2 = 0; kb2 < NKB; ++kb2)
#pragma unroll
                for (int i = 0; i < 16; ++i) sv[kb2][i] = nm_run;
            const LAS unsigned char* kb_ = lds + st * STAGE + koff + sub * 32 * NKB * KP;
#pragma unroll
            for (int kh = 0; kh < 2; ++kh) {
                bf16x8 kfr[2][NKB];
#pragma unroll
                for (int k2 = 0; k2 < 2; ++k2)
#pragma unroll
                    for (int kb2 = 0; kb2 < NKB; ++kb2) kfr[k2][kb2] = *(const LAS bf16x8*)(kb_ + (32 * kb2 + r) * KP + (2 * kh + k2) * 32 + h * 16);
                if (NKB == 2) asm volatile("" : "+v"(kfr[0][0]), "+v"(kfr[0][1]), "+v"(kfr[1][0]), "+v"(kfr[1][1]));
                else asm volatile("" : "+v"(kfr[0][0]), "+v"(kfr[0][1]), "+v"(kfr[0][NKB - 2]), "+v"(kfr[0][NKB - 1]), "+v"(kfr[1][0]), "+v"(kfr[1][1]), "+v"(kfr[1][NKB - 2]), "+v"(kfr[1][NKB - 1]));
#pragma unroll
                for (int k2 = 0; k2 < 2; ++k2)
#pragma unroll
                    for (int kb2 = 0; kb2 < NKB; ++kb2) sv[kb2] = MFMA32(kfr[k2][kb2], qf[2 * kh + k2], sv[kb2]);
            }
            if (MODE == 0) {
#pragma unroll
                for (int kb2 = 0; kb2 < NKB; ++kb2) {
                    const unsigned wsel = ((kb2 & 1) ? (unsigned)(mw[kb2 >> 1] >> 32) : (unsigned)mw[kb2 >> 1]) >> (4 * h);
#pragma unroll
                    for (int i = 0; i < 16; ++i) { const int cb = (i & 3) + 8 * (i >> 2); if (!((wsel >> cb) & 1u)) sv[kb2][i] = -1e30f; }
                }
            } else if (key0 + 32 * NKB - 1 > q0) {
                const int qq = q0 + r;
#pragma unroll
                for (int kb2 = 0; kb2 < NKB; ++kb2)
#pragma unroll
                    for (int i = 0; i < 16; ++i) { if (key0 + 32 * kb2 + crow(i, h) > qq) sv[kb2][i] = -1e30f; }
            }
            float mx = -1e30f;
#pragma unroll
            for (int kb2 = 0; kb2 < NKB; ++kb2)
#pragma unroll
                for (int i = 0; i < 16; ++i) mx = __builtin_fmaxf(mx, sv[kb2][i]);
            mx = __builtin_fmaxf(mx, shx(mx, 32, lane));
            if (__ballot(mx > 8.0f)) {
                const float delta = __builtin_fmaxf(mx, 0.f);
                const float alpha = __builtin_amdgcn_exp2f(-delta);
                nm_run -= delta; l_run *= alpha;
#pragma unroll
                for (int kb2 = 0; kb2 < NKB; ++kb2)
#pragma unroll
                    for (int i = 0; i < 16; ++i) sv[kb2][i] -= delta;
#pragma unroll
                for (int db = 0; db < NDB; ++db)
#pragma unroll
                    for (int i = 0; i < 16; ++i) ot[db][i] *= alpha;
            }
            float ps = 0.f;
#pragma unroll
            for (int kb2 = 0; kb2 < NKB; ++kb2)
#pragma unroll
                for (int i = 0; i < 16; ++i) { sv[kb2][i] = __builtin_amdgcn_exp2f(sv[kb2][i]); ps += sv[kb2][i]; }
            l_run += ps;
            const LAS unsigned char* vb_ = lds + st * STAGE + KBYTES + sub * 32 * NKB * 2;
#pragma unroll
            for (int kb2 = 0; kb2 < NKB; ++kb2)
#pragma unroll
                for (int s = 0; s < 2; ++s) {
                    u32x2 vlo[NDB], vhi[NDB];
#pragma unroll
                    for (int db = 0; db < NDB; ++db) { const LAS unsigned char* vp = vb_ + (32 * db + r) * VP + (32 * kb2 + 16 * s + 4 * h) * 2;
                        vlo[db] = *(const LAS u32x2*)vp; vhi[db] = *(const LAS u32x2*)(vp + 16); }
                    u32x4 pw;
                    pw.x = pk2(sv[kb2][8 * s + 0], sv[kb2][8 * s + 1]); pw.y = pk2(sv[kb2][8 * s + 2], sv[kb2][8 * s + 3]); pw.z = pk2(sv[kb2][8 * s + 4], sv[kb2][8 * s + 5]); pw.w = pk2(sv[kb2][8 * s + 6], sv[kb2][8 * s + 7]);
                    const bf16x8 pf = __builtin_bit_cast(bf16x8, pw);
                    if (NDB == 2) asm volatile("" : "+v"(vlo[0]), "+v"(vhi[0]), "+v"(vlo[1]), "+v"(vhi[1]));
                    else asm volatile("" : "+v"(vlo[0]), "+v"(vhi[0]), "+v"(vlo[1]), "+v"(vhi[1]), "+v"(vlo[NDB - 2]), "+v"(vhi[NDB - 2]), "+v"(vlo[NDB - 1]), "+v"(vhi[NDB - 1]));
#pragma unroll
                    for (int db = 0; db < NDB; ++db) { const u32x4 vw = {vlo[db].x, vlo[db].y, vhi[db].x, vhi[db].y};
                        ot[db] = MFMA32(__builtin_bit_cast(bf16x8, vw), pf, ot[db]); }
                }
        }
        }
        if (more && PV != 1) ATT_STORE(st ^ 1);
        __syncthreads();
    }
#undef ATT_LOAD
#undef ATT_STORE
    const float l = l_run + shx(l_run, 32, lane);
    const float inv = 1.0f / l;
    if (MODE == 0) {
#pragma unroll
        for (int db = 0; db < NDB; ++db)
#pragma unroll
            for (int g = 0; g < 4; ++g) { u32x2 o; o.x = pk2(ot[db][4 * g] * inv, ot[db][4 * g + 1] * inv); o.y = pk2(ot[db][4 * g + 2] * inv, ot[db][4 * g + 3] * inv);
                *(u32x2*)(obase + (rowbase + q0 + r) * ldo + wave * 64 + 32 * db + 8 * g + 4 * h) = o; }
    } else {
        LAS float* xch = (LAS float*)lds;
        const int map = wave >> 2, sub = wave & 3;
        if (map == 1) {
#pragma unroll
            for (int db = 0; db < NDB; ++db)
#pragma unroll
                for (int i = 0; i < 16; ++i) xch[((sub * 4 + db) * 16 + i) * 64 + lane] = ot[db][i] * inv;
        }
        __syncthreads();
        if (map == 0) {
            float ss = 0.f;
#pragma unroll
            for (int db = 0; db < NDB; ++db)
#pragma unroll
                for (int i = 0; i < 16; ++i) { const float o = ot[db][i] * inv - lam * xch[((sub * 4 + db) * 16 + i) * 64 + lane]; ot[db][i] = o; ss += o * o; }
            ss += shx(ss, 32, lane);
            const float rstd = osc / sqrtf(ss * (1.f / 128.f) + EPS);
            bf16_t* orow = obase + (rowbase + q0 + r) * ldo + hd * 128;
#pragma unroll
            for (int db = 0; db < NDB; ++db)
#pragma unroll
                for (int g = 0; g < 4; ++g) { const int d = 32 * db + 8 * g + 4 * h; const f32x4 gg = *(const f32x4*)(gsub + d);
                    u32x2 o; o.x = pk2(ot[db][4 * g] * rstd * gg.x, ot[db][4 * g + 1] * rstd * gg.y); o.y = pk2(ot[db][4 * g + 2] * rstd * gg.z, ot[db][4 * g + 3] * rstd * gg.w);
                    *(u32x2*)(orow + d) = o; }
        }
        __syncthreads();
    }
}

#ifndef PROBE_NBITS
#define PROBE_NBITS 1
#endif
#ifndef PROBE_IDX_PARTS
#define PROBE_IDX_PARTS 3
#endif
#ifndef PROBE_REP
#define PROBE_REP 0
#endif
typedef const __attribute__((address_space(4))) Args CArgs;
#define PH_BEGIN \
    CArgs* ap = (CArgs*)__builtin_amdgcn_kernarg_segment_ptr(); asm volatile("" : "+s"(ap)); \
    int wv_ = wave_s; asm volatile("" : "+s"(wv_)); \
    int ln_; asm volatile("v_mbcnt_lo_u32_b32 %0, -1, 0\n\tv_mbcnt_hi_u32_b32 %0, -1, %0" : "=v"(ln_)); \
    const int wave = wv_, lane = ln_; \
    const int tid = wave * 64 + lane; \
    const int G = gridDim.x, bx = blockIdx.x; \
    const int vcu = (G % 8 == 0) ? (bx % 8) * (G / 8) + bx / 8 : bx;     \
    const int gw = bx * NWAVES + wave, ngw = G * NWAVES, gtid = bx * NTHR + tid, nthr = G * NTHR; \
    unsigned char* ws = ap->ws; float* H = ap->out; \
    (void)vcu; (void)lane; (void)gw; (void)ngw; (void)gtid; (void)nthr; (void)H; (void)ws
#define XB_TMO      128
#define XB_XCNT(j)  (256  + 64 * (j))
#define XB_XSUB(j)  (1280 + 64 * (j))
#define XB_XGEN(j)  (2304 + 64 * (j))
#define XB_TOP      3328
#define XB_TOPGEN   3392
#define XB_SPIN_CAP (1u << 20)
DI unsigned xb_ld(unsigned* p)              { return __hip_atomic_load(p, __ATOMIC_RELAXED, __HIP_MEMORY_SCOPE_AGENT); }
DI unsigned xb_add(unsigned* p, unsigned v) { return __hip_atomic_fetch_add(p, v, __ATOMIC_RELAXED, __HIP_MEMORY_SCOPE_AGENT); }
DI unsigned xb_xcc_id() { return (unsigned)__builtin_amdgcn_s_getreg((3 << 11) | 20) & 0xFu; }
#define XB_SPIN(cond, bar) do { unsigned _sp = 0; while (cond) { __builtin_amdgcn_s_sleep(1); \
    if ((++_sp & 255u) == 0u) { if (xb_ld(&(bar)[XB_TMO])) break; if (_sp > XB_SPIN_CAP) { atomicAdd(&(bar)[XB_TMO], 1u); break; } } } } while (0)
DI void xb_complete(unsigned* bar, unsigned x, unsigned G, unsigned& nloc, unsigned& nx) {
    unsigned sum, cnt, mine, sp = 0u;
    for (;;) {
        sum = 0u; cnt = 0u; mine = 0u;
#pragma unroll
        for (unsigned j = 0; j < 16; ++j) { const unsigned c = xb_ld(&bar[XB_XCNT(j)]); sum += c; cnt += (c > 0u) ? 1u : 0u; mine = (j == x) ? c : mine; }
        if (sum == G) break;
        __builtin_amdgcn_s_sleep(1);
        if ((++sp & 255u) == 0u) { if (xb_ld(&bar[XB_TMO])) break; if (sp > XB_SPIN_CAP) { atomicAdd(&bar[XB_TMO], 1u); break; } }
    }
    nloc = mine > 0u ? mine : 1u; nx = cnt > 0u ? cnt : 1u;
}
DI void grid_bar(unsigned* bar, volatile LAS unsigned* st, unsigned G, int tid) {
    asm volatile("s_waitcnt vmcnt(0)" ::: "memory");
    __syncthreads();
    if (tid == 0) {
        __builtin_amdgcn_s_waitcnt(0);
        const unsigned x = xb_xcc_id();
        unsigned nloc = st[0], nx = st[1];
        if (nloc == 0u) { xb_complete(bar, x, G, nloc, nx); st[0] = nloc; st[1] = nx; }
        const unsigned old = xb_add(&bar[XB_XSUB(x)], 1u);
        const unsigned gen = old / nloc;
        if (old + 1u == (gen + 1u) * nloc) {
            __builtin_amdgcn_fence(__ATOMIC_RELEASE, "agent");
            asm volatile("s_waitcnt vmcnt(0)" ::: "memory");
            const unsigned og = xb_add(&bar[XB_TOP], 1u);
            const unsigned tg = og / nx;
            if (og + 1u == (tg + 1u) * nx) xb_add(&bar[XB_TOPGEN], 1u);
            else XB_SPIN(xb_ld(&bar[XB_TOPGEN]) == tg, bar);
            __builtin_amdgcn_fence(__ATOMIC_ACQUIRE, "agent");
            xb_add(&bar[XB_XGEN(x)], 1u);
            asm volatile("s_waitcnt vmcnt(0)" ::: "memory");
        } else {
            XB_SPIN(xb_ld(&bar[XB_XGEN(x)]) == gen, bar);
            __builtin_amdgcn_fence(__ATOMIC_ACQUIRE, "agent");
            asm volatile("s_waitcnt vmcnt(0)" ::: "memory");
        }
    }
    __syncthreads();
}
#define GRID_BAR() do { PH_BEGIN; grid_bar((unsigned*)ws, (volatile LAS unsigned*)(lds + LDS_BYTES - 64), (unsigned)G, tid); } while (0)
#define XN_ ((bf16_t*)(ws + WS_XN))
#define PROJ_ ((bf16_t*)(ws + WS_PROJ))

__global__ void __launch_bounds__(NTHR) hybrid_fwd(Args a_unused) {
    extern __shared__ __attribute__((aligned(16))) unsigned char lds_raw[];
    LAS unsigned char* lds = (LAS unsigned char*)lds_raw;
    cg::this_grid().sync();
    const int wave_s = __builtin_amdgcn_readfirstlane((int)threadIdx.x >> 6);
    { PH_BEGIN;
      if (tid == 0) { volatile LAS unsigned* st = (volatile LAS unsigned*)(lds + LDS_BYTES - 64); st[0] = 0u; st[1] = 0u; (void)xb_add(&((unsigned*)ws)[XB_XCNT(xb_xcc_id())], 1u); }
      __syncthreads(); }

    { PH_BEGIN;
      rope_table((float*)(ws + WS_ROPE), gtid, nthr); }
    { PH_BEGIN;
        LAS float* scr = (LAS float*)(lds + wave * 16384);
        constexpr int I_IN = (DM / 64) * (NINP / 32), I_UP = (DM / 64) * (NUP / 32), I_DN = (DFF / 64) * (DM / 32), I_B = (512 / 64) * (DM / 32), I_SQ = (DM / 64) * (DM / 32), I_PP = (PLE / 64) * (DM / 32);
        constexpr int PER_L = I_IN + I_UP + I_DN + 2 * I_B + 2 * I_SQ + I_PP;
#pragma unroll 1
        for (int it = gw; it < DEPTH * PER_L; it += ngw) {
            const int l = it / PER_L; int r = it % PER_L;
            if (r < I_IN) { transpose_item<1>(ap->in[3] + (size_t)l * DM * NIN, DM, NIN, NINP, (bf16_t*)(ws + WS_WIN + l * SZ_WIN), scr, r, lane, ap->in[2] + l * DM); continue; } r -= I_IN;
            if (r < I_UP) { transpose_item<0>(ap->in[17] + (size_t)l * DM * NUP, DM, NUP, NUP, (bf16_t*)(ws + WS_WUP + l * SZ_WUP), scr, r, lane, ap->in[16] + l * DM); continue; } r -= I_UP;
            const float* W; int K; bf16_t* WT; const float* gk = nullptr;
            if (r < I_DN) { W = ap->in[20] + (size_t)l * DFF * DM; K = DFF; WT = (bf16_t*)(ws + WS_WDN + l * SZ_WDN); }
            else { r -= I_DN;
            if (r < I_B) { W = ap->in[13] + (size_t)l * 512 * DM; K = 512; WT = (bf16_t*)(ws + WS_WBA + l * SZ_WB); }
            else { r -= I_B;
            if (r < I_B) { W = ap->in[14] + (size_t)l * 512 * DM; K = 512; WT = (bf16_t*)(ws + WS_WBB + l * SZ_WB); }
            else { r -= I_B;
            if (r < I_SQ) { W = ap->in[15] + (size_t)l * DM * DM; K = DM; WT = (bf16_t*)(ws + WS_WOUT + l * SZ_WSQ); }
            else { r -= I_SQ;
            if (r < I_SQ) { W = ap->in[22] + (size_t)l * DM * DM; K = DM; WT = (bf16_t*)(ws + WS_WPG + l * SZ_WSQ); gk = ap->in[21] + l * DM; }
            else { r -= I_SQ; W = ap->in[23] + (size_t)l * PLE * DM; K = PLE; WT = (bf16_t*)(ws + WS_WPP + l * SZ_WPP); } } } } }
            transpose_item<0>(W, K, DM, DM, WT, scr, r, lane, gk);
        }
    }
    { PH_BEGIN;
#pragma unroll 1
      for (int m = gw; m < M; m += 2 * ngw) { const int m2 = m + ngw;
        if (m2 < M) raw_rows2_to_bf16(ap->in[0] + (size_t)m * DM, ap->in[0] + (size_t)m2 * DM, (bf16_t*)H + (size_t)m * DM, (bf16_t*)H + (size_t)m2 * DM, (float*)(ws + WS_RSTD) + m, (float*)(ws + WS_RSTD) + m2, lane);
        else raw_row_to_bf16(ap->in[0] + (size_t)m * DM, (bf16_t*)H + (size_t)m * DM, (float*)(ws + WS_RSTD) + m, lane); } }
    GRID_BAR();

#pragma unroll 1
    for (int l = 0; l < DEPTH; ++l) {
        { PH_BEGIN; pg8::Gemm g{(const bf16_t*)H, (const bf16_t*)(ws + WS_WIN + l * SZ_WIN), M, NINP, DM, DM}; pg8::StaticOrder S; S.init(M, NINP, G, bx);
          pg8::EpiStore<0, true> E{PROJ_, NINP, (const float*)(ws + WS_RSTD)};
          pg8::gemm_phase<pg8::EpiStore<0, true>, pg8::StaticOrder, true, true>(lds, g, S, E, tid); }
        GRID_BAR();
        { PH_BEGIN; const float* rope = (const float*)(ws + WS_ROPE);
#pragma unroll 1
          for (int m = gw; m < M; m += ngw) qk_post_token(PROJ_ + (size_t)m * NINP, rope + (size_t)(m % SEQ) * 64, ap->in[4] + l * 64, ap->in[5] + l * 64, ap->in[6] + l * 64, ap->in[7] + l * 64, lane); }
        { PH_BEGIN;
#pragma unroll 1
          for (int tile = gw; tile < (M / 64) * 9; tile += ngw) vt_tile(PROJ_, (bf16_t*)(ws + WS_VTA), (bf16_t*)(ws + WS_VTB), (LAS bf16_t*)(lds + wave * 9216), tile, lane); }
        GRID_BAR();
        { PH_BEGIN;
            float* scr = (float*)(ws + WS_XN) + (size_t)bx * 32 * SEQ;
#pragma unroll 1
            for (int k = 0; vcu + (k >> 1) * G < NB * 32; ++k) { const int u = k, pr = vcu + (k >> 1) * G, b = pr >> 5, j = pr & 31;
                idx_unit<3>(PROJ_, (unsigned long long*)(ws + WS_MASK), scr, lds, b, (u & 1) ? j : 63 - j, tid, wave, lane);
                }
            __syncthreads();
        }
        { PH_BEGIN;
            const float lam_init = l == 0 ? 0.2f : 0.35550906759f;
            const float sa = wave_sum(ap->in[8][l * 64 + lane] * ap->in[9][l * 64 + lane], lane), sb = wave_sum(ap->in[10][l * 64 + lane] * ap->in[11][l * 64 + lane], lane);
            const float lam = __builtin_amdgcn_exp2f(sa * 1.4426950408889634f) - __builtin_amdgcn_exp2f(sb * 1.4426950408889634f) + lam_init;
#pragma unroll 1
            for (int k = 0; vcu + (k >> 1) * G < NB * 4 * 8; ++k) { const int u = k, pr = vcu + (k >> 1) * G, b = pr >> 5, hd = (pr >> 3) & 3, j = pr & 7;
                attn_unit<1>(PROJ_, PROJ_ + C_QB, NINP, (const bf16_t*)(ws + WS_VTB), nullptr, lds, b, hd, (u & 1) ? j : 15 - j, ap->in[12] + l * 128, lam, 1.f - lam_init, tid, wave, lane); }
        }
        __syncthreads();
        { PH_BEGIN;
#pragma unroll 1
          for (int k = 0; vcu + (k >> 1) * G < NB * 32; ++k) { const int u = k, pr = vcu + (k >> 1) * G, b = pr >> 5, j = pr & 31;
            attn_unit<0>(PROJ_, PROJ_ + C_QA, NINP, (const bf16_t*)(ws + WS_VTA), (const unsigned long long*)(ws + WS_MASK), lds, b, 0, (u & 1) ? j : 63 - j, nullptr, 0.f, 0.f, tid, wave, lane); } }
        GRID_BAR();
        { PH_BEGIN; pg8::Gemm g{PROJ_ + C_QA, (const bf16_t*)(ws + WS_WBA + l * SZ_WB), M, DM, 512, NINP}; pg8::StaticOrder S; S.init(M, DM, G, bx);
          pg8::EpiGate<false> E{(bf16_t*)(ws + WS_MIX), DM, PROJ_ + C_GA, NINP};
          pg8::gemm_phase<pg8::EpiGate<false>, pg8::StaticOrder, true, true>(lds, g, S, E, tid); }
        { PH_BEGIN; pg8::Gemm g{PROJ_ + C_QB, (const bf16_t*)(ws + WS_WBB + l * SZ_WB), M, DM, 512, NINP}; pg8::StaticOrder S; S.init(M, DM, G, bx);
          pg8::EpiGate<true> E{(bf16_t*)(ws + WS_MIX), DM, PROJ_ + C_GB, NINP};
          pg8::gemm_phase<pg8::EpiGate<true>, pg8::StaticOrder, true, true>(lds, g, S, E, tid); }
        GRID_BAR();
        { PH_BEGIN; pg8::Gemm g{(const bf16_t*)(ws + WS_MIX), (const bf16_t*)(ws + WS_WOUT + l * SZ_WSQ), M, DM, DM, DM}; pg8::StaticOrder S; S.init(M, DM, G, bx);
          pg8::EpiRes<false> E{l == 0 ? ap->in[0] : nullptr, (const bf16_t*)H, nullptr, DM, nullptr, (bf16_t*)(ws + WS_HB), (float*)(ws + WS_PSSQ)};
          pg8::gemm_phase<pg8::EpiRes<false>, pg8::StaticOrder, true, true>(lds, g, S, E, tid); }
        GRID_BAR();
        { PH_BEGIN; rstd_phase((const float*)(ws + WS_PSSQ), (float*)(ws + WS_RSTD), gtid, nthr); }
        GRID_BAR();
#pragma unroll 1
        for (int c = 0; c < 2; ++c) {
            { PH_BEGIN; pg8::Gemm g{(const bf16_t*)(ws + WS_HB) + (size_t)c * MC * DM, (const bf16_t*)(ws + WS_WUP + l * SZ_WUP), MC, NUP, DM, DM}; pg8::StaticOrder S; S.init(MC, NUP, G, bx);
              pg8::EpiStore<0, true> E{(bf16_t*)(ws + WS_UP), NUP, (const float*)(ws + WS_RSTD) + (size_t)c * MC};
              pg8::gemm_phase<pg8::EpiStore<0, true>, pg8::StaticOrder, true, true>(lds, g, S, E, tid); }
            GRID_BAR();
            { PH_BEGIN; conv_phase((const bf16_t*)(ws + WS_UP), (bf16_t*)(ws + WS_ACT) + (size_t)c * MC * DFF, ap->in[18] + (size_t)l * 3 * NUP, ap->in[19] + (size_t)l * NUP, gtid, nthr); }
            if (c == 0) { PH_BEGIN; const f32x4* ps = (const f32x4*)(ap->in[1] + (size_t)l * M * PLE); u32x2* pd = (u32x2*)(ws + WS_PB);
#pragma unroll 1
              for (int i = gtid; i < M * PLE / 4; i += 4 * nthr) {
                  f32x4 v[4];
#pragma unroll
                  for (int k = 0; k < 4; ++k) v[k] = (i + k * nthr < M * PLE / 4) ? __builtin_nontemporal_load(ps + i + k * nthr) : (f32x4){0.f, 0.f, 0.f, 0.f};
#pragma unroll
                  for (int k = 0; k < 4; ++k) if (i + k * nthr < M * PLE / 4) { u32x2 o; o.x = pk2(v[k].x, v[k].y); o.y = pk2(v[k].z, v[k].w); pd[i + k * nthr] = o; } } }
            GRID_BAR();
        }
        { PH_BEGIN; pg8::Gemm g{(const bf16_t*)(ws + WS_ACT), (const bf16_t*)(ws + WS_WDN + l * SZ_WDN), M, DM, DFF, DFF}; pg8::StaticOrder S; S.init(M, DM, G, bx);
          bf16_t* HBp = (bf16_t*)(ws + WS_HB);
          pg8::EpiRes<false> E{nullptr, HBp, nullptr, DM, nullptr, HBp, (float*)(ws + WS_PSSQ)};
          pg8::gemm_phase<pg8::EpiRes<false>, pg8::StaticOrder, true, true>(lds, g, S, E, tid); }
        GRID_BAR();
        { PH_BEGIN; rstd_phase((const float*)(ws + WS_PSSQ), (float*)(ws + WS_RSTD), gtid, nthr); }
        GRID_BAR();
        { PH_BEGIN; pg8::Gemm g{(const bf16_t*)(ws + WS_HB), (const bf16_t*)(ws + WS_WPG + l * SZ_WSQ), M, DM, DM, DM}; pg8::StaticOrder S; S.init(M, DM, G, bx);
          pg8::EpiStore<1, true> E{(bf16_t*)(ws + WS_G), DM, (const float*)(ws + WS_RSTD)};
          pg8::gemm_phase<pg8::EpiStore<1, true>, pg8::StaticOrder, true, true>(lds, g, S, E, tid); }
        { PH_BEGIN; pg8::Gemm g{(const bf16_t*)(ws + WS_PB), (const bf16_t*)(ws + WS_WPP + l * SZ_WPP), M, DM, PLE, PLE}; pg8::StaticOrder S; S.init(M, DM, G, bx);
          pg8::EpiRes<true> E{nullptr, (const bf16_t*)(ws + WS_HB), l + 1 < DEPTH ? nullptr : H, DM, (const bf16_t*)(ws + WS_G), l + 1 < DEPTH ? (bf16_t*)H : nullptr, (float*)(ws + WS_PSSQ)};
          pg8::gemm_phase<pg8::EpiRes<true>, pg8::StaticOrder, true, true>(lds, g, S, E, tid); }
        if (l + 1 < DEPTH) {
            GRID_BAR();
            { PH_BEGIN; rstd_phase((const float*)(ws + WS_PSSQ), (float*)(ws + WS_RSTD), gtid, nthr); }
            GRID_BAR();
        }
    }
}

extern "C" void kernel_launch(void* const* d_in, const int* in_sizes, int n_in, void* d_out, int out_size, void* d_ws, size_t ws_size, hipStream_t stream) {
    static int grid = 0;
    if (grid == 0) {
        if (n_in != 24 || out_size != M * DM || ws_size < WS_END2) { fprintf(stderr, "kernel_launch: unexpected sizes n_in %d out %d ws %zu (need %zu)\n", n_in, out_size, ws_size, (size_t)WS_END2); grid = -1; return; }
        int dev = 0, cus = 0, per_cu = 0;
        hipGetDevice(&dev); hipDeviceGetAttribute(&cus, hipDeviceAttributeMultiprocessorCount, dev);
        if (hipFuncSetAttribute((const void*)hybrid_fwd, hipFuncAttributeMaxDynamicSharedMemorySize, LDS_BYTES) != hipSuccess) { fprintf(stderr, "kernel_launch: hipFuncSetAttribute failed\n"); grid = -1; return; }
        if (hipOccupancyMaxActiveBlocksPerMultiprocessor(&per_cu, (const void*)hybrid_fwd, NTHR, LDS_BYTES) != hipSuccess || per_cu < 1) { fprintf(stderr, "kernel_launch: occupancy query says %d\n", per_cu); per_cu = 1; }
        (void)hipGetLastError();
        grid = cus;
    }
    if (grid < 0) return;
    if (hipMemsetAsync(d_ws, 0, 16384, stream) != hipSuccess) { fprintf(stderr, "kernel_launch: memset failed\n"); return; }
    Args a{};
    for (int i = 0; i < 24; ++i) a.in[i] = (const float*)d_in[i];
    a.out = (float*)d_out; a.ws = (unsigned char*)d_ws;
    void* args[] = {&a};
    hipError_t e = hipLaunchCooperativeKernel((const void*)hybrid_fwd, dim3(grid), dim3(NTHR), args, LDS_BYTES, stream);
    if (e != hipSuccess) fprintf(stderr, "cooperative launch failed: %s (grid %d)\n", hipGetErrorString(e), grid);
}
```
